# Optimizing an MI355X kernel written in HIP

```python
import math
import jax
import jax.numpy as jnp
from jax import lax
import numpy as np

D_MODEL = 1024
BATCH = 16
SEQ = 256
DEPTH = 4
DEC_BATCH = 2
DEC_SEQ = 4096
PAST_LEN = 512

GRID_W = 64
N_AB = (DEPTH + 1) // 2
N_HY = DEPTH // 2
CHUNK = 64
EPS = 1e-6
A_HEADS = 4
A_DK = 128
A_DV = 128
A_QK_W = A_HEADS * A_DK
A_V_W = A_HEADS * A_DV
A_CONV_W = 2 * A_QK_W + A_V_W
SHORT_K = 3
B_HEADS = 4
B_DK = 128
B_DV = 128
B_QK_W = B_HEADS * B_DK
B_V_W = B_HEADS * B_DV
MIX_W = A_V_W + B_V_W
AB_IN = A_CONV_W + A_V_W + 4 * A_HEADS + 2 * B_QK_W + 2 * B_V_W
HY_SHORT_K = 3
HY_EMB = 33
HY_BANDS = (HY_EMB - 1) // 2
HY_FW = 64
HY_TARGET = 1e-2
HY_FAST_PCT = 0.3
HY_SLOW_PCT = 1.5
D_FF = 2816
FFN_K = 3

kernel_name = "hybrid_flow_trunk_prefix_ctx"


def rmsnorm(x, g):
    xf = x.astype(jnp.float32)
    y = xf * lax.rsqrt(jnp.mean(xf * xf, axis=-1, keepdims=True) + EPS)
    return (y * g.astype(jnp.float32)).astype(x.dtype)


def head_groupnorm(x, g):
    xf = x.astype(jnp.float32)
    mu = jnp.mean(xf, axis=-1, keepdims=True)
    var = jnp.mean(jnp.square(xf - mu), axis=-1, keepdims=True)
    return (xf - mu) * lax.rsqrt(var + EPS) * g.astype(jnp.float32)


def l2norm(x):
    xf = x.astype(jnp.float32)
    return xf * lax.rsqrt(jnp.sum(xf * xf, axis=-1, keepdims=True) + EPS)


def modulate(h, shift, scale):
    return h * (1.0 + scale) + shift


def split_cols(x, sizes):
    idx = np.cumsum(sizes)[:-1].tolist()
    return jnp.split(x, idx, axis=-1)


def heads(x, n):
    b, l, _ = x.shape
    return x.reshape(b, l, n, -1).transpose(0, 2, 1, 3)


def flip_if(t, rev):
    return jnp.flip(t, axis=2) if rev else t


def dwconv1d(x, w):
    k = w.shape[0]
    p = k // 2
    l = x.shape[1]
    xp = jnp.pad(x, ((0, 0), (p, p), (0, 0)))
    out = xp[:, 0:l] * w[0]
    for i in range(1, k):
        out = out + xp[:, i:i + l] * w[i]
    return out


def dwconv2d_grid(x, w):
    b, l, ch = x.shape
    rows = l // GRID_W
    xg = jnp.pad(x.reshape(b, rows, GRID_W, ch), ((0, 0), (1, 1), (1, 1), (0, 0)))
    out = xg[:, 0:rows, 0:GRID_W] * w[0, 0]
    for i in range(3):
        for j in range(3):
            if i == 0 and j == 0:
                continue
            out = out + xg[:, i:i + rows, j:j + GRID_W] * w[i, j]
    return out.reshape(b, l, ch)


def gated_delta_chunked(q, k, v, g, beta, s0):
    f32 = jnp.float32
    b, h, l, dk = q.shape
    dv = v.shape[-1]
    n = l // CHUNK
    q = q.astype(f32).reshape(b, h, n, CHUNK, dk)
    k = k.astype(f32).reshape(b, h, n, CHUNK, dk)
    v = v.astype(f32).reshape(b, h, n, CHUNK, dv)
    g = g.astype(f32).reshape(b, h, n, CHUNK)
    beta = beta.astype(f32).reshape(b, h, n, CHUNK)
    gc = jnp.cumsum(g, axis=-1)
    tril = jnp.tril(jnp.ones((CHUNK, CHUNK), bool))
    stril = jnp.tril(jnp.ones((CHUNK, CHUNK), bool), -1)
    diff = gc[..., :, None] - gc[..., None, :]
    dmask = jnp.where(tril, jnp.exp(jnp.where(tril, diff, 0.0)), 0.0)
    kb = k * beta[..., None]
    lmat = jnp.where(stril, jnp.einsum('bhncd,bhnsd->bhncs', kb, k) * dmask, 0.0)
    eye = jnp.eye(CHUNK, dtype=f32)
    tmat = lax.linalg.triangular_solve(eye + lmat, jnp.broadcast_to(eye, lmat.shape),
                                       left_side=True, lower=True)
    u = tmat @ (v * beta[..., None])
    w = tmat @ (kb * jnp.exp(gc)[..., None])
    attn = jnp.where(tril, jnp.einsum('bhncd,bhnsd->bhncs', q, k) * dmask, 0.0)
    qd = q * jnp.exp(gc)[..., None]
    kd = k * jnp.exp(gc[..., -1:] - gc)[..., None]
    gl = jnp.exp(gc[..., -1])

    def step(s, xs):
        u_i, w_i, attn_i, qd_i, kd_i, gl_i = xs
        v_new = u_i - w_i @ s
        o_i = qd_i @ s + attn_i @ v_new
        s = s * gl_i[..., None, None] + jnp.swapaxes(kd_i, -1, -2) @ v_new
        return s, o_i

    xs = tuple(jnp.moveaxis(t, 2, 0) for t in (u, w, attn, qd, kd, gl))
    s_fin, o = lax.scan(step, s0.astype(f32), xs)
    o = jnp.moveaxis(o, 0, 2).reshape(b, h, l, dv)
    return o, s_fin


def retention_chunked(q, k, v, log_gamma, r0):
    f32 = jnp.float32
    b, h, l, dk = q.shape
    dv = v.shape[-1]
    n = l // CHUNK
    q = q.astype(f32).reshape(b, h, n, CHUNK, dk)
    k = k.astype(f32).reshape(b, h, n, CHUNK, dk)
    v = v.astype(f32).reshape(b, h, n, CHUNK, dv)
    lg = log_gamma.astype(f32)[:, None]
    idx = jnp.arange(CHUNK, dtype=f32)
    diff = idx[:, None] - idx[None, :]
    dmat = jnp.where(diff >= 0, jnp.exp(jnp.maximum(diff, 0.0)[None] * lg[..., None]), 0.0)
    cross_decay = jnp.exp((idx + 1.0)[None] * lg)
    state_decay = jnp.exp((CHUNK - 1.0 - idx)[None] * lg)
    chunk_decay = jnp.exp(CHUNK * lg[:, 0])
    inner = jnp.einsum('bhncd,bhnsd->bhncs', q, k) * dmat[None, :, None]
    o_inner = jnp.einsum('bhncs,bhnsv->bhncv', inner, v)
    kv = jnp.einsum('bhncd,bhncv->bhndv', k * state_decay[None, :, None, :, None], v)

    def step(r, kv_i):
        return r * chunk_decay[None, :, None, None] + kv_i, r

    r_fin, r_prev = lax.scan(step, r0.astype(f32), jnp.moveaxis(kv, 2, 0))
    r_prev = jnp.moveaxis(r_prev, 0, 2)
    o = o_inner + jnp.einsum('bhncd,bhndv->bhncv', q * cross_decay[None, :, None, :, None], r_prev)
    return o.reshape(b, h, l, dv), r_fin


def mixer_ab(h, w_in, conv_a, a_log, dt_bias, norm_a, norm_b, ret_decay, w_out, s_delta0, s_ret0):
    f32 = jnp.float32
    bsz, l, _ = h.shape
    proj = h @ w_in
    qkv_a, z_a, a_raw, b_raw, q_b, k_b, v_b, g_b = split_cols(
        proj, [A_CONV_W, A_V_W, 2 * A_HEADS, 2 * A_HEADS, B_QK_W, B_QK_W, B_V_W, B_V_W])
    qkv_a = jax.nn.silu(dwconv1d(qkv_a, conv_a))
    q_a, k_a, v_a = split_cols(qkv_a, [A_QK_W, A_QK_W, A_V_W])
    q_a = l2norm(heads(q_a, A_HEADS)) * (A_DK ** -0.5)
    k_a = l2norm(heads(k_a, A_HEADS))
    v_a = heads(v_a, A_HEADS)
    g_a = -jnp.exp(a_log.astype(f32)) * jax.nn.softplus(
        a_raw.astype(f32).reshape(bsz, l, 2, A_HEADS) + dt_bias.astype(f32))
    beta_a = jax.nn.sigmoid(b_raw.astype(f32).reshape(bsz, l, 2, A_HEADS))
    g_a = g_a.transpose(2, 0, 3, 1)
    beta_a = beta_a.transpose(2, 0, 3, 1)
    q_b = heads(q_b, B_HEADS) * (B_DK ** -0.5)
    k_b = heads(k_b, B_HEADS)
    v_b = heads(v_b, B_HEADS)
    log_gamma = -jnp.exp(ret_decay.astype(f32))
    o_a = 0.0
    o_b = 0.0
    fin_a = []
    fin_b = []
    for d in range(2):
        rev = d == 1
        oa, sa = gated_delta_chunked(flip_if(q_a, rev), flip_if(k_a, rev), flip_if(v_a, rev),
                                     flip_if(g_a[d], rev), flip_if(beta_a[d], rev), s_delta0[:, d])
        ob, sb = retention_chunked(flip_if(q_b, rev), flip_if(k_b, rev), flip_if(v_b, rev),
                                   log_gamma[d], s_ret0[:, d])
        o_a = o_a + flip_if(oa, rev)
        o_b = o_b + flip_if(ob, rev)
        fin_a.append(sa)
        fin_b.append(sb)
    z = z_a.astype(f32).reshape(bsz, l, A_HEADS, A_DV)
    o_a = rmsnorm(o_a.transpose(0, 2, 1, 3), norm_a) * jax.nn.silu(z)
    gb = g_b.astype(f32).reshape(bsz, l, B_HEADS, B_DV)
    o_b = head_groupnorm(o_b.transpose(0, 2, 1, 3), norm_b) * jax.nn.silu(gb)
    o = jnp.concatenate([o_a.reshape(bsz, l, A_V_W), o_b.reshape(bsz, l, B_V_W)], axis=-1).astype(h.dtype)
    return o @ w_out, jnp.stack(fin_a, axis=1), jnp.stack(fin_b, axis=1)


def hyena_filter(l, w1, b1, freq1, w2, b2, freq2, w3):
    f32 = jnp.float32
    t = jnp.linspace(0.0, 1.0, l, dtype=f32)[:, None]
    wpos = 2.0 * math.pi * jnp.arange(l, dtype=f32)[:, None] / l
    bands = jnp.linspace(1e-4, HY_BANDS - 1, HY_BANDS, dtype=f32)[None, :]
    z = jnp.concatenate([t, jnp.cos(bands * wpos), -jnp.sin(bands * wpos)], axis=-1)
    hid = jnp.sin(freq1 * (z @ w1 + b1))
    hid = jnp.sin(freq2 * (hid @ w2 + b2))
    filt = (hid @ w3).astype(f32)
    min_decay = math.log(HY_TARGET) / HY_SLOW_PCT
    max_decay = math.log(HY_TARGET) / HY_FAST_PCT
    deltas = jnp.abs(jnp.linspace(min_decay, max_decay, D_MODEL, dtype=f32))
    window = jnp.exp(-t * deltas[None, :])
    return filt[:, :D_MODEL] * window, filt[:, D_MODEL:] * window


def bidir_long_conv(u, h_fwd, h_bwd, bias):
    f32 = jnp.float32
    l = u.shape[1]
    kern = jnp.concatenate([h_fwd, jnp.zeros((1, h_fwd.shape[1]), f32), jnp.flip(h_bwd[1:], axis=0)], axis=0)
    uf = jnp.fft.rfft(u.astype(f32), n=2 * l, axis=1)
    kf = jnp.fft.rfft(kern, axis=0)
    y = jnp.fft.irfft(uf * kf[None], n=2 * l, axis=1)[:, :l]
    return (y + u.astype(f32) * bias.astype(f32)).astype(u.dtype)


def mixer_hyena(h, w_in, b_in, conv_w, conv_b, f_w1, f_b1, f_freq1, f_w2, f_b2, f_freq2, f_w3, f_bias, w_out, b_out):
    l = h.shape[1]
    u = dwconv1d(h @ w_in + b_in, conv_w) + conv_b
    x0, x1, v = split_cols(u, [D_MODEL, D_MODEL, D_MODEL])
    h_fwd, h_bwd = hyena_filter(l, f_w1, f_b1, f_freq1, f_w2, f_b2, f_freq2, f_w3)
    v = bidir_long_conv(v * x1, h_fwd, h_bwd, f_bias)
    return (v * x0) @ w_out + b_out


def conv_ffn(h, w_gate, w_up, w_conv, b_conv, w_down, on_grid):
    gate = h @ w_gate
    up = h @ w_up
    gate = dwconv2d_grid(gate, w_conv) if on_grid else dwconv1d(gate, w_conv[1])
    return (jax.nn.silu(gate + b_conv) * up) @ w_down


def setup_inputs(seed: int = 0) -> dict:
    key = jax.random.key(seed)
    ks = iter(jax.random.split(key, 48))
    f32 = jnp.float32
    D = D_MODEL

    def nrm(shape, scale=1.0):
        return jax.random.normal(next(ks), shape, f32) * scale

    def gain(shape):
        return 1.0 + nrm(shape, 0.05)

    ret_base = jnp.log(-jnp.log(1.0 - 2.0 ** (-5.0 - jnp.arange(B_HEADS, dtype=f32))))
    dt = jnp.exp(jax.random.uniform(next(ks), (N_AB, 2, A_HEADS), f32, math.log(1e-3), math.log(1e-1)))
    a_log = jnp.log(jax.random.uniform(next(ks), (N_AB, 2, A_HEADS), f32, 1.0, 16.0))
    return {
        "x_prompt": nrm((BATCH, SEQ, D)),
        "x_sample": nrm((DEC_BATCH, DEC_SEQ, D)),
        "state_delta": nrm((DEC_BATCH, N_AB, 2, A_HEADS, A_DK, A_DV), 0.3),
        "state_ret": nrm((DEC_BATCH, N_AB, 2, B_HEADS, B_DK, B_DV), 1.0),
        "c": nrm((DEC_BATCH, D)),
        "c_ctx": nrm((D,)),
        "mod_w": nrm((DEPTH, D, 6 * D), 0.5 * D ** -0.5),
        "mod_b": nrm((DEPTH, 6 * D), 0.02),
        "norm1": gain((DEPTH, D)),
        "norm2": gain((DEPTH, D)),
        "ab_w_in": nrm((N_AB, D, AB_IN), D ** -0.5),
        "ab_conv": nrm((N_AB, SHORT_K, A_CONV_W), SHORT_K ** -0.5),
        "ab_a_log": a_log,
        "ab_dt_bias": dt + jnp.log(-jnp.expm1(-dt)),
        "ab_norm_a": gain((N_AB, A_DV)),
        "ab_norm_b": gain((N_AB, B_DV)),
        "ab_ret_decay": ret_base[None, None, :] + nrm((N_AB, 2, B_HEADS), 0.05),
        "ab_w_out": nrm((N_AB, MIX_W, D), MIX_W ** -0.5),
        "hy_w_in": nrm((N_HY, D, 3 * D), D ** -0.5),
        "hy_b_in": nrm((N_HY, 3 * D), 0.02),
        "hy_conv_w": nrm((N_HY, HY_SHORT_K, 3 * D), HY_SHORT_K ** -0.5),
        "hy_conv_b": nrm((N_HY, 3 * D), 0.02),
        "hy_f_w1": nrm((N_HY, HY_EMB, HY_FW), HY_EMB ** -0.5),
        "hy_f_b1": nrm((N_HY, HY_FW), 0.1),
        "hy_f_freq1": gain((N_HY, HY_FW)),
        "hy_f_w2": nrm((N_HY, HY_FW, HY_FW), HY_FW ** -0.5),
        "hy_f_b2": nrm((N_HY, HY_FW), 0.1),
        "hy_f_freq2": gain((N_HY, HY_FW)),
        "hy_f_w3": nrm((N_HY, HY_FW, 2 * D), 0.02),
        "hy_f_bias": nrm((N_HY, D), 0.5),
        "hy_w_out": nrm((N_HY, D, D), D ** -0.5),
        "hy_b_out": nrm((N_HY, D), 0.02),
        "ffn_w_gate": nrm((DEPTH, D, D_FF), D ** -0.5),
        "ffn_w_up": nrm((DEPTH, D, D_FF), D ** -0.5),
        "ffn_conv": nrm((DEPTH, FFN_K, FFN_K, D_FF), 1.0 / FFN_K),
        "ffn_conv_b": nrm((DEPTH, D_FF), 0.02),
        "ffn_w_down": nrm((DEPTH, D_FF, D), D_FF ** -0.5),
        "final_norm": gain((D,)),
    }


def reference(x_prompt, x_sample, state_delta, state_ret, c, c_ctx, mod_w, mod_b, norm1, norm2,
              ab_w_in, ab_conv, ab_a_log, ab_dt_bias, ab_norm_a, ab_norm_b, ab_ret_decay, ab_w_out,
              hy_w_in, hy_b_in, hy_conv_w, hy_conv_b, hy_f_w1, hy_f_b1, hy_f_freq1, hy_f_w2, hy_f_b2,
              hy_f_freq2, hy_f_w3, hy_f_bias, hy_w_out, hy_b_out,
              ffn_w_gate, ffn_w_up, ffn_conv, ffn_conv_b, ffn_w_down, final_norm):
    f32 = jnp.float32
    n_ctx_b = x_prompt.shape[0]
    xc, xl = x_prompt, x_sample
    sc_ctx = jax.nn.silu(c_ctx)[None, None, :]
    sc_lat = jax.nn.silu(c)[:, None, :]
    new_delta = []
    new_ret = []
    for l in range(DEPTH):
        mc = jnp.split(sc_ctx @ mod_w[l] + mod_b[l], 6, axis=-1)
        ml = jnp.split(sc_lat @ mod_w[l] + mod_b[l], 6, axis=-1)
        hc = modulate(rmsnorm(xc, norm1[l]), mc[0], mc[1])
        hl = modulate(rmsnorm(xl, norm1[l]), ml[0], ml[1])
        j = l // 2
        if l % 2 == 0:
            ab = (ab_w_in[j], ab_conv[j], ab_a_log[j], ab_dt_bias[j], ab_norm_a[j], ab_norm_b[j],
                  ab_ret_decay[j], ab_w_out[j])
            zd = jnp.zeros((n_ctx_b, 2, A_HEADS, A_DK, A_DV), f32)
            zr = jnp.zeros((n_ctx_b, 2, B_HEADS, B_DK, B_DV), f32)
            oc, sd, sr = mixer_ab(hc, *ab, zd, zr)
            ol, _, _ = mixer_ab(hl, *ab, state_delta[:, j], state_ret[:, j])
            new_delta.append(sd)
            new_ret.append(sr)
        else:
            hy = (hy_w_in[j], hy_b_in[j], hy_conv_w[j], hy_conv_b[j], hy_f_w1[j], hy_f_b1[j], hy_f_freq1[j],
                  hy_f_w2[j], hy_f_b2[j], hy_f_freq2[j], hy_f_w3[j], hy_f_bias[j], hy_w_out[j], hy_b_out[j])
            oc = mixer_hyena(hc, *hy)
            ol = mixer_hyena(hl, *hy)
        xc = xc + mc[2] * oc
        xl = xl + ml[2] * ol
        ffn = (ffn_w_gate[l], ffn_w_up[l], ffn_conv[l], ffn_conv_b[l], ffn_w_down[l])
        hc = modulate(rmsnorm(xc, norm2[l]), mc[3], mc[4])
        hl = modulate(rmsnorm(xl, norm2[l]), ml[3], ml[4])
        xc = xc + mc[5] * conv_ffn(hc, *ffn, on_grid=False)
        xl = xl + ml[5] * conv_ffn(hl, *ffn, on_grid=True)
    y_prompt = rmsnorm(xc, final_norm)
    y_sample = rmsnorm(xl, final_norm)
    new_state_delta = jnp.stack(new_delta, axis=1)
    new_state_ret = jnp.stack(new_ret, axis=1)
    return (y_prompt, y_sample, new_state_delta, new_state_ret)
```

```cpp
#include <hip/hip_runtime.h>
#include <hip/hip_cooperative_groups.h>
#include <cstdio>
namespace cg = cooperative_groups;
__device__ __forceinline__ int ltid() { int t = threadIdx.x; asm volatile("" : "+v"(t)); return t; }
__device__ __forceinline__ int lbid() { int t = blockIdx.x; asm volatile("" : "+s"(t)); return t; }
namespace pg8 {
#define PG8_LAS __attribute__((address_space(3)))
typedef unsigned short bf16_t;
typedef short bf16x8 __attribute__((ext_vector_type(8)));
typedef float f32x4 __attribute__((ext_vector_type(4)));
typedef unsigned u32x4 __attribute__((ext_vector_type(4)));
constexpr int BM = 256, BK = 64, HALF = 128, HTB = HALF * BK * 2  , STAGE_BYTES = 8 * HTB, NXCD = 8, WGM = 8;

__host__ __device__ __forceinline__ int lds_byte(int r, int c) { const int st = (r >> 4) * 2 + (c >> 5), rr = r & 15, cc = c & 31, ob = rr * 64 + cc * 2; return st * 1024 + (ob ^ (((ob >> 9) & 1) << 5)); }
__host__ __device__ __forceinline__ void stage_rc(int b, int& R, int& C) { const int st = b / 1024, sb = b % 1024, swz = sb ^ (((sb >> 9) & 1) << 5); R = (st >> 1) * 16 + swz / 64; C = (st & 1) * 32 + (swz % 64) / 2; }
__host__ __device__ __forceinline__ int perm32(int rho) { const int n = rho >> 4, i = rho & 15; return 8 * (i >> 2) + 4 * n + (i & 3); }

struct Unit { int pm, pn; };
struct Gemm { const bf16_t* A; const bf16_t* Bt; int M, N, K; };

struct StaticOrder {
    int nM, nN, nwg, G, c;
    __host__ __device__ void init(int M, int N, int G_, int c_) { nM = M / BM; nN = N / BM; nwg = nM * nN; G = G_; c = c_; }
    __host__ __device__ bool next(int i, Unit& u) const {
        const long L = (long)i * G + c; if (L >= nwg) return false;
        int wgid = (int)L; { const int q = nwg / NXCD, r = nwg % NXCD, xcd = wgid % NXCD, off = wgid / NXCD; wgid = (xcd < r ? xcd * (q + 1) : r * (q + 1) + (xcd - r) * q) + off; }
        const int nig = WGM * nN, gid = wgid / nig, fm = gid * WGM, gsz = (nM - fm) < WGM ? (nM - fm) : WGM;
        u.pm = fm + ((wgid % nig) % gsz); u.pn = (wgid % nig) / gsz; return true;
    }
    __device__ __forceinline__ void a_ready(const Unit&) const {}
    __device__ __forceinline__ void done(const Unit&) const {}
};
__device__ __forceinline__ unsigned cvt_pk_bf16(float lo, float hi) {
    typedef __bf16 bf2_t __attribute__((ext_vector_type(2))); typedef float f2_t __attribute__((ext_vector_type(2)));
    f2_t v = {lo, hi}; bf2_t r = __builtin_convertvector(v, bf2_t); return __builtin_bit_cast(unsigned, r); }
typedef float f32x2 __attribute__((ext_vector_type(2)));
template <class Epi, class Sched, bool STAMP = false>
__device__ __forceinline__ void gemm_phase(PG8_LAS unsigned char* lds, const Gemm g, const Sched& S, const Epi& E, unsigned long long* stamps) {
    const int tid = ltid(), wid = __builtin_amdgcn_readfirstlane(tid >> 6), lane = tid & 63, wr = wid >> 2, wc = wid & 3, fr = lane & 15, fq = lane >> 4;
    const int K = g.K, nt = K / BK;
    int ts_lo = 0, ts_hi = 0, nts = 0; const unsigned long long rt_entry = STAMP ? (unsigned long long)wall_clock64() : 0ull;
#define PG8_STAMP() do { if (STAMP && wid == 0 && nts < 64) { const unsigned long long _c = (unsigned long long)clock64(); \
        ts_lo = (lane == nts) ? (int)(unsigned)_c : ts_lo; ts_hi = (lane == nts) ? (int)(unsigned)(_c >> 32) : ts_hi; ++nts; } } while (0)
    PG8_STAMP();
    unsigned voffA[2], voffB[2];
#pragma unroll
    for (int i = 0; i < 2; ++i) { int R, C; stage_rc(tid * 16 + i * 8192, R, C); const int Rb = Epi::PERM ? ((R & ~31) + perm32(R & 31)) : R;
        voffA[i] = (unsigned)(R * K + C) * 2u; voffB[i] = (unsigned)(Rb * K + C) * 2u; }
    const size_t kstep = (size_t)(BK * 2);
    const size_t hstep = (size_t)HALF * K * 2;
    const size_t tstep = 2 * hstep;
    const unsigned ldsw = (unsigned)wid * 1024u;
    const int aoff = lds_byte(wr * 64 + fr, fq * 8), boff = lds_byte(wc * 32 + fr, fq * 8);
#define PG8_SA(b, h) (((b) * 2 + (h)) * HTB)
#define PG8_SB(b, h) ((4 + (b) * 2 + (h)) * HTB)
#define PG8_STAGE(bufoff, gbase, voff) do { _Pragma("unroll") for (int _i = 0; _i < 2; ++_i) \
        __builtin_amdgcn_global_load_lds((const unsigned*)((const char*)(gbase) + (voff)[_i]), (PG8_LAS unsigned*)(lds + (bufoff) + ldsw + _i * 8192), 16, 0, 0); } while (0)
#define PG8_LDA(dst, b, h) do { _Pragma("unroll") for (int m = 0; m < 4; ++m) _Pragma("unroll") for (int k = 0; k < 2; ++k) dst[m][k] = *(const PG8_LAS bf16x8*)(lds + PG8_SA(b, h) + aoff + m * 2048 + k * 1024); } while (0)
#define PG8_LDB(dst, b, h) do { _Pragma("unroll") for (int n = 0; n < 2; ++n) _Pragma("unroll") for (int k = 0; k < 2; ++k) dst[n][k] = *(const PG8_LAS bf16x8*)(lds + PG8_SB(b, h) + boff + n * 2048 + k * 1024); } while (0)
#define PG8_MMA(ai, bj, At, Bt) do { __builtin_amdgcn_s_setprio(1); _Pragma("unroll") for (int m = 0; m < 4; ++m) _Pragma("unroll") for (int n = 0; n < 2; ++n) _Pragma("unroll") for (int k = 0; k < 2; ++k) \
        acc[ai][bj][m][n] = __builtin_amdgcn_mfma_f32_16x16x32_bf16(Bt[n][k], At[m][k], acc[ai][bj][m][n], 0, 0, 0); __builtin_amdgcn_s_setprio(0); } while (0)
#define PG8_WAIT_V(n) asm volatile("s_waitcnt vmcnt(" #n ")" ::: "memory")
#define PG8_WAIT_L(n) asm volatile("s_waitcnt lgkmcnt(" #n ")" ::: "memory")
#define PG8_BAR __builtin_amdgcn_s_barrier()
#define PG8_SCHED __builtin_amdgcn_sched_barrier(0)
    Unit cur, nxt; int ui = 0;
    if (!S.next(0, cur)) return;
    f32x4 acc[2][2][4][2];
#pragma unroll
    for (int a = 0; a < 2; ++a)
#pragma unroll
        for (int b = 0; b < 2; ++b)
#pragma unroll
            for (int m = 0; m < 4; ++m)
#pragma unroll
                for (int n = 0; n < 2; ++n) acc[a][b][m][n] = (f32x4){0.f, 0.f, 0.f, 0.f};
    bf16x8 At[4][2], B0[2][2], B1[2][2];
    const char* cA = (const char*)g.A + (size_t)cur.pm * tstep; const char* cB = (const char*)g.Bt + (size_t)cur.pn * tstep;
    S.a_ready(cur);
    PG8_STAGE(PG8_SB(0, 0), cB, voffB); PG8_STAGE(PG8_SA(0, 0), cA, voffA); PG8_STAGE(PG8_SB(0, 1), cB + hstep, voffB); PG8_STAGE(PG8_SA(0, 1), cA + hstep, voffA);
    if (wr == 1) PG8_BAR;
    PG8_WAIT_V(4); PG8_BAR;
    PG8_STAGE(PG8_SB(1, 0), cB + kstep, voffB); PG8_STAGE(PG8_SA(1, 0), cA + kstep, voffA); PG8_STAGE(PG8_SB(1, 1), cB + hstep + kstep, voffB);
    PG8_WAIT_V(6); PG8_BAR;
    PG8_STAMP();
    for (;;) {
        const bool has_next = S.next(ui + 1, nxt);
        const char* nA = has_next ? (const char*)g.A + (size_t)nxt.pm * tstep : cA; const char* nB = has_next ? (const char*)g.Bt + (size_t)nxt.pn * tstep : cB;
        for (int t = 0; t < nt; t += 2) {
            const bool last = (t == nt - 2);
            const char* a1 = cA + (size_t)(t + 1) * kstep;
            const char* a2 = last ? nA : cA + (size_t)(t + 2) * kstep; const char* b2 = last ? nB : cB + (size_t)(t + 2) * kstep;
            const char* a3 = a2 + kstep; const char* b3 = b2 + kstep;
            if (last && has_next) S.a_ready(nxt);
            PG8_LDB(B0, 0, 0); PG8_SCHED; PG8_LDA(At, 0, 0); PG8_STAGE(PG8_SA(1, 1), a1 + hstep, voffA);
            PG8_WAIT_L(8); PG8_BAR; PG8_WAIT_L(0); PG8_MMA(0, 0, At, B0); PG8_BAR; PG8_SCHED;
            PG8_LDB(B1, 0, 1); PG8_STAGE(PG8_SB(0, 0), b2, voffB);
            PG8_BAR; PG8_WAIT_L(0); PG8_MMA(0, 1, At, B1); PG8_BAR;
            PG8_LDA(At, 0, 1); PG8_STAGE(PG8_SA(0, 0), a2, voffA);
            PG8_BAR; PG8_WAIT_L(0); PG8_MMA(1, 0, At, B0); PG8_BAR; PG8_SCHED;
            PG8_STAGE(PG8_SB(0, 1), b2 + hstep, voffB);
            PG8_WAIT_V(6); PG8_BAR; PG8_MMA(1, 1, At, B1); PG8_BAR;
            PG8_LDB(B0, 1, 0); PG8_SCHED; PG8_LDA(At, 1, 0); PG8_STAGE(PG8_SA(0, 1), a2 + hstep, voffA);
            PG8_WAIT_L(8); PG8_BAR; PG8_WAIT_L(0); PG8_MMA(0, 0, At, B0); PG8_BAR; PG8_SCHED;
            PG8_LDB(B1, 1, 1); PG8_STAGE(PG8_SB(1, 0), b3, voffB);
            PG8_BAR; PG8_WAIT_L(0); PG8_MMA(0, 1, At, B1); PG8_BAR;
            PG8_LDA(At, 1, 1); PG8_STAGE(PG8_SA(1, 0), a3, voffA);
            PG8_BAR; PG8_WAIT_L(0); PG8_MMA(1, 0, At, B0); PG8_BAR; PG8_SCHED;
            PG8_STAGE(PG8_SB(1, 1), b3 + hstep, voffB);
            PG8_WAIT_V(6); PG8_BAR; PG8_MMA(1, 1, At, B1); PG8_BAR;
        }
        PG8_STAMP();
        if constexpr (!Epi::AFTER_DRAIN) { E(acc, cur, wr, wc, fr, fq); S.done(cur); }
        PG8_STAMP();
        if (!has_next) break;
#pragma unroll
        for (int a = 0; a < 2; ++a)
#pragma unroll
            for (int b = 0; b < 2; ++b)
#pragma unroll
                for (int m = 0; m < 4; ++m)
#pragma unroll
                    for (int n = 0; n < 2; ++n) acc[a][b][m][n] = (f32x4){0.f, 0.f, 0.f, 0.f};
        cur = nxt; cA = nA; cB = nB; ++ui;
    }
    PG8_WAIT_V(0);
    if (wr == 0) PG8_BAR;
    PG8_BAR;
    if constexpr (Epi::AFTER_DRAIN) { E.fused(acc, cur, wr, wc, fr, fq, lds, wid, lane); S.done(cur); }
    PG8_STAMP();
    if (STAMP && wid == 0) { stamps[lane] = lane < nts ? (((unsigned long long)(unsigned)ts_hi << 32) | (unsigned)ts_lo) : 0ull;
        if (lane == 62) stamps[62] = rt_entry; if (lane == 63) stamps[63] = (unsigned long long)wall_clock64(); }
#undef PG8_STAMP
#undef PG8_SA
#undef PG8_SB
#undef PG8_STAGE
#undef PG8_LDA
#undef PG8_LDB
#undef PG8_MMA
#undef PG8_WAIT_V
#undef PG8_WAIT_L
#undef PG8_BAR
#undef PG8_SCHED
}
}

using pg8::bf16_t; using pg8::bf16x8; using pg8::f32x4; using pg8::u32x4; using pg8::cvt_pk_bf16;

constexpr int NTOK = 12288, DM = 1024, NCTX = 4096;
constexpr size_t MB = 1048576;
constexpr size_t OFF_WIN = 0, OFF_WOUT = 8 * MB, OFF_WGU = 10 * MB, OFF_WDN = 21 * MB, OFF_H = 27 * MB, OFF_MOD = 51 * MB, OFF_SIDE = 52 * MB,
                 OFF_HID2 = 53 * MB, OFF_GL = 54 * MB + MB / 2, OFF_BIG = 55 * MB;
constexpr size_t B_QKV = OFF_BIG, B_ZG = OFF_BIG + 72 * MB, B_PREPD = OFF_BIG + 96 * MB, B_PREPR = B_PREPD + 108 * MB, B_ODIR = OFF_BIG;
constexpr size_t B_U = OFF_BIG, B_VXT = OFF_BIG + 72 * MB, B_KERN = OFF_BIG + 120 * MB, B_KERN256 = B_KERN + 32 * MB;
constexpr size_t B_GU = OFF_BIG, B_ACT = OFF_BIG + 132 * MB;
constexpr size_t WS_NEED = 343 * MB;
constexpr int LDS_BYTES = 144 * 1024;
constexpr int ITEM_D = 73728, ITEM_R = 57344;
constexpr int PO_QD = 0, PO_KDT = 8192, PO_ATT = 16384, PO_U = 20480, PO_W = 28672;

enum { I_XP = 0, I_XS, I_SD, I_SR, I_C, I_CCTX, I_MODW, I_MODB, I_NORM1, I_NORM2, I_ABWIN, I_ABCONV, I_ALOG, I_DTB, I_NA, I_NB, I_RDEC, I_ABWOUT,
       I_HYWIN, I_HYBIN, I_HYCW, I_HYCB, I_FW1, I_FB1, I_FF1, I_FW2, I_FB2, I_FF2, I_FW3, I_FBIAS, I_HYWOUT, I_HYBOUT, I_FG, I_FU, I_FCONV, I_FCB, I_FD, I_FNORM, N_IN };

struct Params { const float* in[N_IN]; float* out; unsigned char* ws; int lo, hi; };

__device__ __forceinline__ float wsum(float v) {
#pragma unroll
    for (int o = 32; o; o >>= 1) v += __shfl_xor(v, o);
    return v; }
__device__ __forceinline__ bf16_t f2bf(float f) { return (bf16_t)(cvt_pk_bf16(f, 0.f) & 0xffffu); }
__device__ __forceinline__ float bf2f(bf16_t b) { return __uint_as_float(((unsigned)b) << 16); }
__device__ __forceinline__ float bflo(unsigned u) { return __uint_as_float(u << 16); }
__device__ __forceinline__ float bfhi(unsigned u) { return __uint_as_float(u & 0xffff0000u); }
__device__ __forceinline__ float silu(float x) { return x / (1.0f + __expf(-x)); }
__device__ __forceinline__ void tokinfo(int tok, int& sbase, int& L) { if (tok < NCTX) { sbase = tok & ~255; L = 256; } else { sbase = NCTX + ((tok - NCTX) & ~4095); L = 4096; } }
__device__ __forceinline__ void unpack8(const uint4 u, float* f) { f[0] = bflo(u.x); f[1] = bfhi(u.x); f[2] = bflo(u.y); f[3] = bfhi(u.y); f[4] = bflo(u.z); f[5] = bfhi(u.z); f[6] = bflo(u.w); f[7] = bfhi(u.w); }
__device__ __forceinline__ uint4 pack8(const float* f) { uint4 u; u.x = cvt_pk_bf16(f[0], f[1]); u.y = cvt_pk_bf16(f[2], f[3]); u.z = cvt_pk_bf16(f[4], f[5]); u.w = cvt_pk_bf16(f[6], f[7]); return u; }

struct EpiBf16S {
    static constexpr bool PERM = true, AFTER_DRAIN = false;
    bf16_t* O1; int ld1; int nsplit; bf16_t* O2; int ld2; const float* bias;
    __device__ __forceinline__ void operator()(const f32x4 (&acc)[2][2][4][2], const pg8::Unit& u, int wr, int wc, int fr, int fq) const {
        const int row0 = u.pm * 256 + wr * 64 + fr; bf16_t* base; int ldc, colt;
        if (u.pn < nsplit) { base = O1; ldc = ld1; colt = u.pn * 256; } else { base = O2; ldc = ld2; colt = (u.pn - nsplit) * 256; }
        const int col0 = colt + wc * 32 + 8 * fq, bcol0 = u.pn * 256 + wc * 32 + 8 * fq;
#pragma unroll
        for (int bj = 0; bj < 2; ++bj) {
            f32x4 b0 = {0.f, 0.f, 0.f, 0.f}, b1 = {0.f, 0.f, 0.f, 0.f};
            if (bias) { b0 = *(const f32x4*)(bias + bcol0 + bj * 128); b1 = *(const f32x4*)(bias + bcol0 + bj * 128 + 4); }
#pragma unroll
            for (int ai = 0; ai < 2; ++ai)
#pragma unroll
                for (int m = 0; m < 4; ++m) {
                    bf16_t* rowp = base + (size_t)(row0 + ai * 128 + m * 16) * ldc + col0 + bj * 128;
                    f32x4 v0 = acc[ai][bj][m][0] + b0, v1 = acc[ai][bj][m][1] + b1;
                    u32x4 w; w.x = cvt_pk_bf16(v0[0], v0[1]); w.y = cvt_pk_bf16(v0[2], v0[3]); w.z = cvt_pk_bf16(v1[0], v1[1]); w.w = cvt_pk_bf16(v1[2], v1[3]);
                    *(u32x4*)rowp = w; }
        }
    }
};
struct EpiRes {
    static constexpr bool PERM = false, AFTER_DRAIN = false;
    float* X; const float* gate; const float* bias;
    __device__ __forceinline__ void operator()(const f32x4 (&acc)[2][2][4][2], const pg8::Unit& u, int wr, int wc, int fr, int fq) const {
        const int row0 = u.pm * 256 + wr * 64 + fr, col0 = u.pn * 256 + wc * 32 + 4 * fq;
        const int vec = (u.pm < 16) ? 0 : 1 + ((u.pm - 16) >> 4);
        const float* g = gate + vec * 6144;
#pragma unroll
        for (int bj = 0; bj < 2; ++bj)
#pragma unroll
            for (int n = 0; n < 2; ++n) {
                const int c = col0 + bj * 128 + n * 16;
                const f32x4 gv = *(const f32x4*)(g + c);
                f32x4 bv = {0.f, 0.f, 0.f, 0.f}; if (bias) bv = *(const f32x4*)(bias + c);
#pragma unroll
                for (int ai = 0; ai < 2; ++ai)
#pragma unroll
                    for (int m = 0; m < 4; ++m) {
                        float* px = X + (size_t)(row0 + ai * 128 + m * 16) * DM + c;
                        f32x4 xv = *(const f32x4*)px; xv += gv * (acc[ai][bj][m][n] + bv); *(f32x4*)px = xv; }
            }
    }
};

template <class Epi> __device__ __forceinline__ void run_gemm(unsigned char* shm, const bf16_t* A, const bf16_t* Bt, int N, int K, const Epi& E) {
    pg8::Gemm g; g.A = A; g.Bt = Bt; g.M = NTOK; g.N = N; g.K = K;
    pg8::StaticOrder S; S.init(NTOK, N, (int)gridDim.x, lbid());
    pg8::gemm_phase<Epi, pg8::StaticOrder, false>((PG8_LAS unsigned char*)shm, g, S, E, nullptr);
}

__device__ __forceinline__ void conv_seg(const float* __restrict__ src, int ld, int K, int col0, int ncols, bf16_t* __restrict__ dst, int& base, float* tile) {
    const int nkt = K >> 6, n = nkt * (ncols >> 6), G = (int)gridDim.x;
    const int start = (lbid() - base % G + G) % G;
    for (int it = start; it < n; it += G) {
        const int kt = it % nkt, ct = it / nkt;
        const float* s = src + (size_t)(kt * 64) * ld + col0 + ct * 64;
        const int cc = ltid() & 63, kk0 = ltid() >> 6;
#pragma unroll
        for (int i = 0; i < 8; ++i) tile[(kk0 + 8 * i) * 65 + cc] = s[(size_t)(kk0 + 8 * i) * ld + cc];
        __syncthreads();
        const int kk2 = (ltid() & 31) * 2, c2 = ltid() >> 5;
#pragma unroll
        for (int i = 0; i < 4; ++i) { const int c = c2 + 16 * i; const unsigned v = cvt_pk_bf16(tile[kk2 * 65 + c], tile[(kk2 + 1) * 65 + c]);
            *(unsigned*)(dst + (size_t)(ct * 64 + c) * K + kt * 64 + kk2) = v; }
        __syncthreads();
    }
    base += n;
}
__device__ __forceinline__ void convert_mixer(const Params& p, int l, unsigned char* shm) {
    float* tile = (float*)shm; int base = 0; const int j = l >> 1;
    bf16_t* win = (bf16_t*)(p.ws + OFF_WIN); bf16_t* wout = (bf16_t*)(p.ws + OFF_WOUT);
    if ((l & 1) == 0) {
        const float* w = p.in[I_ABWIN] + (size_t)j * 1024 * 4112;
        conv_seg(w, 4112, 1024, 0, 1536, win, base, tile);
        conv_seg(w, 4112, 1024, 2064, 1536, win + (size_t)1536 * 1024, base, tile);
        conv_seg(w, 4112, 1024, 1536, 512, win + (size_t)3072 * 1024, base, tile);
        conv_seg(w, 4112, 1024, 3600, 512, win + (size_t)3584 * 1024, base, tile);
        conv_seg(p.in[I_ABWOUT] + (size_t)j * 1024 * 1024, 1024, 1024, 0, 1024, wout, base, tile);
    } else {
        conv_seg(p.in[I_HYWIN] + (size_t)j * 1024 * 3072, 3072, 1024, 0, 3072, win, base, tile);
        conv_seg(p.in[I_HYWOUT] + (size_t)j * 1024 * 1024, 1024, 1024, 0, 1024, wout, base, tile);
    }
}
__device__ __forceinline__ void convert_ffn(const Params& p, int l, unsigned char* shm) {
    float* tile = (float*)shm; int base = 0;
    bf16_t* wgu = (bf16_t*)(p.ws + OFF_WGU); bf16_t* wdn = (bf16_t*)(p.ws + OFF_WDN);
    conv_seg(p.in[I_FG] + (size_t)l * 1024 * 2816, 2816, 1024, 0, 2816, wgu, base, tile);
    conv_seg(p.in[I_FU] + (size_t)l * 1024 * 2816, 2816, 1024, 0, 2816, wgu + (size_t)2816 * 1024, base, tile);
    conv_seg(p.in[I_FD] + (size_t)l * 2816 * 1024, 1024, 2816, 0, 1024, wdn, base, tile);
}

__device__ __forceinline__ void phase_prologue(const Params& p, unsigned char* shm) {
    const int tid = ltid(), G = (int)gridDim.x;
    {   const float4* a = (const float4*)p.in[I_XP]; const float4* b = (const float4*)p.in[I_XS]; float4* o = (float4*)p.out;
        const size_t na = (size_t)NCTX * DM / 4, nt = (size_t)NTOK * DM / 4;
        for (size_t i = (size_t)lbid() * 512 + tid; i < nt; i += (size_t)G * 512) o[i] = i < na ? a[i] : b[i - na]; }
    float* sv = (float*)shm; float* red = sv + 3072;
    for (int i = tid; i < 3072; i += 512) { const int v = i >> 10, k = i & 1023; const float x = v == 0 ? p.in[I_CCTX][k] : p.in[I_C][(v - 1) * 1024 + k]; sv[i] = silu(x); }
    __syncthreads();
    float* MOD = (float*)(p.ws + OFF_MOD);
    for (int it = lbid(); it < 768; it += G) {
        const int l = it / 192, cb = (it % 192) * 32, cl = tid & 31, kg = tid >> 5;
        const float* w = p.in[I_MODW] + (size_t)l * 1024 * 6144 + cb + cl;
        float a0 = 0.f, a1 = 0.f, a2 = 0.f;
#pragma unroll 16
        for (int k = kg * 64; k < kg * 64 + 64; ++k) { const float wv = w[(size_t)k * 6144]; a0 += sv[k] * wv; a1 += sv[1024 + k] * wv; a2 += sv[2048 + k] * wv; }
        red[(0 * 16 + kg) * 32 + cl] = a0; red[(1 * 16 + kg) * 32 + cl] = a1; red[(2 * 16 + kg) * 32 + cl] = a2;
        __syncthreads();
        if (tid < 96) { const int v = tid >> 5, c = tid & 31; float s = 0.f;
#pragma unroll
            for (int q = 0; q < 16; ++q) s += red[(v * 16 + q) * 32 + c];
            MOD[(l * 3 + v) * 6144 + cb + c] = s + p.in[I_MODB][l * 6144 + cb + c]; }
        __syncthreads();
    }
    convert_mixer(p, 0, shm);
}

__device__ __forceinline__ void norm_rows(const Params& p, int l, int which, unsigned char* shm) {
    const int tid = ltid(), lane = tid & 63, wid = tid >> 6;
    const float* nw = which == 0 ? p.in[I_NORM1] + l * 1024 : which == 1 ? p.in[I_NORM2] + l * 1024 : p.in[I_FNORM];
    const bool side = (which == 0) && ((l & 1) == 0);
    float* w16 = (float*)shm;
    if (side) {
        const float* w = p.in[I_ABWIN] + (size_t)(l >> 1) * 1024 * 4112 + 2048;
        for (int i = tid; i < 16384; i += 512) { const int k = i >> 4, jj = i & 15; const int slot = ((k >> 8) * 4 + (k & 3)) * 64 + ((k >> 2) & 63); w16[slot * 16 + jj] = w[(size_t)k * 4112 + jj]; }
        __syncthreads();
    }
    const float* MOD = (const float*)(p.ws + OFF_MOD);
    bf16_t* H = (bf16_t*)(p.ws + OFF_H); float* SIDE = (float*)(p.ws + OFF_SIDE);
    for (int row = lbid() * 8 + wid; row < NTOK; row += (int)gridDim.x * 8) {
        float* xr = p.out + (size_t)row * DM;
        float4 v[4]; float ss = 0.f;
#pragma unroll
        for (int i = 0; i < 4; ++i) { v[i] = *(const float4*)(xr + i * 256 + lane * 4); ss += v[i].x * v[i].x + v[i].y * v[i].y + v[i].z * v[i].z + v[i].w * v[i].w; }
        ss = wsum(ss);
        const float r = rsqrtf(ss * (1.0f / 1024.0f) + 1e-6f);
        if (which == 2) {
#pragma unroll
            for (int i = 0; i < 4; ++i) { const float4 g = *(const float4*)(nw + i * 256 + lane * 4);
                float4 y; y.x = v[i].x * r * g.x; y.y = v[i].y * r * g.y; y.z = v[i].z * r * g.z; y.w = v[i].w * r * g.w; *(float4*)(xr + i * 256 + lane * 4) = y; }
        } else {
            const int vec = row < NCTX ? 0 : 1 + ((row - NCTX) >> 12);
            const float* md = MOD + (l * 3 + vec) * 6144 + (which ? 3072 : 0);
            float sacc[16];
#pragma unroll
            for (int q = 0; q < 16; ++q) sacc[q] = 0.f;
#pragma unroll
            for (int i = 0; i < 4; ++i) { const int k = i * 256 + lane * 4;
                const float4 g = *(const float4*)(nw + k), sh = *(const float4*)(md + k), sc = *(const float4*)(md + 1024 + k);
                float hv[4]; hv[0] = v[i].x * r * g.x * (1.f + sc.x) + sh.x; hv[1] = v[i].y * r * g.y * (1.f + sc.y) + sh.y; hv[2] = v[i].z * r * g.z * (1.f + sc.z) + sh.z; hv[3] = v[i].w * r * g.w * (1.f + sc.w) + sh.w;
                uint2 pk; pk.x = cvt_pk_bf16(hv[0], hv[1]); pk.y = cvt_pk_bf16(hv[2], hv[3]);
                *(uint2*)(H + (size_t)row * DM + k) = pk;
                if (side) {
#pragma unroll
                    for (int e = 0; e < 4; ++e) { const float4* wp = (const float4*)(w16 + ((i * 4 + e) * 64 + lane) * 16);
#pragma unroll
                        for (int q = 0; q < 4; ++q) { const float4 wv = wp[q]; sacc[q * 4 + 0] += hv[e] * wv.x; sacc[q * 4 + 1] += hv[e] * wv.y; sacc[q * 4 + 2] += hv[e] * wv.z; sacc[q * 4 + 3] += hv[e] * wv.w; } }
                }
            }
            if (side) {
#pragma unroll
                for (int q = 0; q < 16; ++q) { const float s = wsum(sacc[q]); if (lane == q) SIDE[(size_t)row * 16 + q] = s; }
            }
        }
    }
}

__device__ __forceinline__ void hyena_hid2(const Params& p, int l, unsigned char* shm) {
    const int tid = ltid(), j = l >> 1;
    float* zf = (float*)shm;
    float* h1 = zf + 8 * 36;
    const float* w1 = p.in[I_FW1] + j * 33 * 64; const float* b1 = p.in[I_FB1] + j * 64; const float* f1 = p.in[I_FF1] + j * 64;
    const float* w2 = p.in[I_FW2] + j * 64 * 64; const float* b2 = p.in[I_FB2] + j * 64; const float* f2 = p.in[I_FF2] + j * 64;
    float* HID2 = (float*)(p.ws + OFF_HID2);
    for (int it = lbid(); it < 544; it += (int)gridDim.x) {
        const int row0 = it * 8;
        if (tid < 8 * 33) { const int r = tid / 33, e = tid % 33; const int rg = row0 + r; const int L = rg < 4096 ? 4096 : 256; const int i = rg < 4096 ? rg : rg - 4096;
            float val;
            if (e == 0) val = (float)i / (float)(L - 1);
            else { const int kb = (e - 1) & 15; const float band = 1e-4f + (float)kb * 0.99999333f; float rr = band * (float)i / (float)L; rr -= floorf(rr);
                val = (e <= 16) ? __builtin_amdgcn_cosf(rr) : -__builtin_amdgcn_sinf(rr); }
            zf[r * 36 + e] = val; }
        __syncthreads();
        const int r = tid >> 6, k = tid & 63;
        { float a = b1[k];
#pragma unroll
          for (int e = 0; e < 33; ++e) a += zf[r * 36 + e] * w1[e * 64 + k];
          h1[r * 64 + k] = __sinf(f1[k] * a); }
        __syncthreads();
        { float a = b2[k];
#pragma unroll 16
          for (int m = 0; m < 64; ++m) a += h1[r * 64 + m] * w2[m * 64 + k];
          HID2[(size_t)(row0 + r) * 64 + k] = __sinf(f2[k] * a); }
        __syncthreads();
    }
}

__device__ __forceinline__ void phase_prep(const Params& p, int l, unsigned char* shm) {
    const int j = l >> 1;
    bf16_t* qs = (bf16_t*)shm;
    bf16_t* ks = qs + 64 * 136;
    bf16_t* vT = ks + 64 * 136;
    bf16_t* kT = vT + 128 * 72;
    bf16_t* kdTs = kT + 128 * 72;
    bf16_t* Ts = kdTs + 128 * 72;
    float* Lm = (float*)(Ts + 64 * 72);
    float* gs = Lm + 64 * 68; float* gcs = gs + 64; float* bts = gcs + 64; float* Xs = bts + 64;
    const bf16_t* QKV = (const bf16_t*)(p.ws + B_QKV); const float* SIDE = (const float*)(p.ws + OFF_SIDE); float* GL = (float*)(p.ws + OFF_GL);
    const float* cw = p.in[I_ABCONV] + j * 3 * 1536;
    for (int it = lbid(); it < 3072; it += (int)gridDim.x) {
        const int tid = ltid(), lane = tid & 63, wid = tid >> 6, fr = lane & 15, fq = lane >> 4;
        const int ty = it / 1536, r1 = it % 1536, d = r1 / 768, r2 = r1 % 768, h = r2 / 192, cgi = r2 % 192;
        const int tok0 = cgi * 64; int sbase, L; tokinfo(tok0, sbase, L);
        bf16_t* item = ty == 0 ? (bf16_t*)(p.ws + B_PREPD + (size_t)((d * 4 + h) * 192 + cgi) * ITEM_D) : (bf16_t*)(p.ws + B_PREPR + (size_t)((d * 4 + h) * 192 + cgi) * ITEM_R);
        const int r_ = tid >> 3, jj = tid & 7;
        const int t = d ? tok0 + 63 - r_ : tok0 + r_;
        uint4 vp0, vp1;
        vp0 = make_uint4(0, 0, 0, 0); vp1 = vp0;
        if (ty == 0) {
#pragma unroll 1
            for (int part = 0; part < 3; ++part) {
                const int col = part * 512 + h * 128 + jj * 16;
                float a[16];
#pragma unroll
                for (int e = 0; e < 16; ++e) a[e] = 0.f;
#pragma unroll 1
                for (int i = 0; i < 3; ++i) { const int tt = t + i - 1;
                    if (tt >= sbase && tt < sbase + L) { const uint4* px = (const uint4*)(QKV + (size_t)tt * 3072 + col); float x[16]; unpack8(px[0], x); unpack8(px[1], x + 8);
#pragma unroll
                        for (int e = 0; e < 16; ++e) a[e] += x[e] * cw[i * 1536 + col + e]; } }
                float ssq = 0.f;
#pragma unroll
                for (int e = 0; e < 16; ++e) { a[e] = silu(a[e]); ssq += a[e] * a[e]; }
                if (part < 2) {
                    ssq += __shfl_xor(ssq, 1); ssq += __shfl_xor(ssq, 2); ssq += __shfl_xor(ssq, 4);
                    const float rn = rsqrtf(ssq + 1e-6f) * (part == 0 ? 0.08838834764831845f : 1.0f);
#pragma unroll
                    for (int e = 0; e < 16; ++e) a[e] *= rn;
                    bf16_t* dq = (part == 0 ? qs : ks) + r_ * 136 + jj * 16;
                    *(uint4*)dq = pack8(a); *(uint4*)(dq + 8) = pack8(a + 8);
                } else { vp0 = pack8(a); vp1 = pack8(a + 8); }
            }
        } else {
            const bf16_t* src = QKV + (size_t)t * 3072 + 1536 + h * 128 + jj * 16;
            { float a[16]; const uint4* px = (const uint4*)src; unpack8(px[0], a); unpack8(px[1], a + 8);
#pragma unroll
              for (int e = 0; e < 16; ++e) a[e] *= 0.08838834764831845f;
              *(uint4*)(qs + r_ * 136 + jj * 16) = pack8(a); *(uint4*)(qs + r_ * 136 + jj * 16 + 8) = pack8(a + 8); }
            { const uint4* px = (const uint4*)(src + 512); *(uint4*)(ks + r_ * 136 + jj * 16) = px[0]; *(uint4*)(ks + r_ * 136 + jj * 16 + 8) = px[1]; }
            { const uint4* px = (const uint4*)(src + 1024); vp0 = px[0]; vp1 = px[1]; }
        }
        if (jj == 0) {
            float g, beta;
            if (ty == 0) { const float a_raw = SIDE[(size_t)t * 16 + d * 4 + h], b_raw = SIDE[(size_t)t * 16 + 8 + d * 4 + h];
                const float A = expf(p.in[I_ALOG][j * 8 + d * 4 + h]); const float x = a_raw + p.in[I_DTB][j * 8 + d * 4 + h];
                const float sp = x > 20.f ? x : log1pf(expf(x)); g = -A * sp; beta = 1.0f / (1.0f + expf(-b_raw)); }
            else { g = -expf(p.in[I_RDEC][j * 8 + d * 4 + h]); beta = 1.f; }
            gs[r_] = g; bts[r_] = beta; }
        __syncthreads();
        if (tid < 64) { float a = 0.f; for (int i = 0; i <= tid; ++i) a += gs[i]; gcs[tid] = a; }
        __syncthreads();
        {   const float gr = gcs[r_], glast = gcs[63], eg = __expf(gr), ek = __expf(glast - gr), b = bts[r_];
            {   float q[16]; unpack8(*(const uint4*)(qs + r_ * 136 + jj * 16), q); unpack8(*(const uint4*)(qs + r_ * 136 + jj * 16 + 8), q + 8);
#pragma unroll
                for (int e = 0; e < 16; ++e) q[e] *= eg;
                *(uint4*)(item + PO_QD + r_ * 128 + jj * 16) = pack8(q); *(uint4*)(item + PO_QD + r_ * 128 + jj * 16 + 8) = pack8(q + 8); }
            if (ty == 1) { *(uint4*)(item + PO_U + r_ * 128 + jj * 16) = vp0; *(uint4*)(item + PO_U + r_ * 128 + jj * 16 + 8) = vp1; }
            {   float k[16]; unpack8(*(const uint4*)(ks + r_ * 136 + jj * 16), k); unpack8(*(const uint4*)(ks + r_ * 136 + jj * 16 + 8), k + 8);
#pragma unroll
                for (int e = 0; e < 16; ++e) { const int col = jj * 16 + e; kdTs[col * 72 + r_] = f2bf(k[e] * ek); if (ty == 0) kT[col * 72 + r_] = f2bf(k[e] * b * eg); } }
            if (ty == 0) { float v[16]; unpack8(vp0, v); unpack8(vp1, v + 8);
#pragma unroll
                for (int e = 0; e < 16; ++e) vT[(jj * 16 + e) * 72 + r_] = f2bf(v[e] * b); }
            if (tid == 0) GL[((ty * 2 + d) * 4 + h) * 192 + cgi] = __expf(glast);
        }
        __syncthreads();
        {
#pragma unroll
            for (int q2 = 0; q2 < 2; ++q2) {
                const int tix = wid * 2 + q2, tm = tix >> 2, tn = tix & 3;
                f32x4 aQ = {0.f, 0.f, 0.f, 0.f}, aK = {0.f, 0.f, 0.f, 0.f};
#pragma unroll
                for (int k0 = 0; k0 < 128; k0 += 32) {
                    const bf16x8 fa = *(const bf16x8*)(qs + (tm * 16 + fr) * 136 + k0 + fq * 8);
                    const bf16x8 fb = *(const bf16x8*)(ks + (tn * 16 + fr) * 136 + k0 + fq * 8);
                    aQ = __builtin_amdgcn_mfma_f32_16x16x32_bf16(fa, fb, aQ, 0, 0, 0);
                    if (ty == 0) { const bf16x8 fk = *(const bf16x8*)(ks + (tm * 16 + fr) * 136 + k0 + fq * 8); aK = __builtin_amdgcn_mfma_f32_16x16x32_bf16(fk, fb, aK, 0, 0, 0); }
                }
#pragma unroll
                for (int jx = 0; jx < 4; ++jx) { const int c = tm * 16 + fq * 4 + jx, s = tn * 16 + fr;
                    const float dec = (s <= c) ? __expf(gcs[c] - gcs[s]) : 0.f;
                    item[PO_ATT + c * 64 + s] = f2bf(aQ[jx] * dec);
                    if (ty == 0) Lm[c * 68 + s] = (s < c) ? bts[c] * aK[jx] * dec : 0.f; }
            }
        }
        __syncthreads();
        if (ty == 0) {
            for (int I = 0; I < 4; ++I) {
                {   const int jc = tid & 63, rr = tid >> 6, r0 = 16 * I + rr, r1 = r0 + 8;
                    float a0 = (r0 == jc) ? 1.f : 0.f, a1 = (r1 == jc) ? 1.f : 0.f;
                    for (int s = 0; s < 16 * I; ++s) { const float xv = Xs[s * 65 + jc]; a0 -= Lm[r0 * 68 + s] * xv; a1 -= Lm[r1 * 68 + s] * xv; }
                    Xs[r0 * 65 + jc] = a0; Xs[r1 * 65 + jc] = a1; }
                __syncthreads();
                if (wid == 0) {
                    float x[16];
                    const float* Lb = Lm + (16 * I) * 68 + 16 * I;
#pragma unroll
                    for (int r = 0; r < 16; ++r) {
                        float a = Xs[(16 * I + r) * 65 + lane];
#pragma unroll
                        for (int s2 = 0; s2 < r; ++s2) a -= Lb[r * 68 + s2] * x[s2];
                        x[r] = a;
                    }
#pragma unroll
                    for (int r = 0; r < 16; ++r) Xs[(16 * I + r) * 65 + lane] = x[r];
                }
                __syncthreads();
            }
#pragma unroll
            for (int i = 0; i < 8; ++i) { const int idx = tid + i * 512; Ts[(idx >> 6) * 72 + (idx & 63)] = f2bf(Xs[(idx >> 6) * 65 + (idx & 63)]); }
            __syncthreads();
#pragma unroll
            for (int q2 = 0; q2 < 4; ++q2) {
                const int tix = wid * 4 + q2, tm = tix >> 3, tn = tix & 7;
                f32x4 aU = {0.f, 0.f, 0.f, 0.f}, aW = {0.f, 0.f, 0.f, 0.f};
#pragma unroll
                for (int k0 = 0; k0 < 64; k0 += 32) {
                    const bf16x8 fa = *(const bf16x8*)(Ts + (tm * 16 + fr) * 72 + k0 + fq * 8);
                    const bf16x8 fu = *(const bf16x8*)(vT + (tn * 16 + fr) * 72 + k0 + fq * 8);
                    const bf16x8 fw = *(const bf16x8*)(kT + (tn * 16 + fr) * 72 + k0 + fq * 8);
                    aU = __builtin_amdgcn_mfma_f32_16x16x32_bf16(fa, fu, aU, 0, 0, 0);
                    aW = __builtin_amdgcn_mfma_f32_16x16x32_bf16(fa, fw, aW, 0, 0, 0);
                }
#pragma unroll
                for (int jx = 0; jx < 4; ++jx) { const int c = tm * 16 + fq * 4 + jx, col = tn * 16 + fr;
                    item[PO_U + c * 128 + col] = f2bf(aU[jx]); item[PO_W + c * 128 + col] = f2bf(aW[jx]); }
            }
        }
#pragma unroll
        for (int i = 0; i < 2; ++i) { const int idx = tid + i * 512, row = idx >> 3, seg = idx & 7; *(uint4*)(item + PO_KDT + row * 64 + seg * 8) = *(const uint4*)(kdTs + row * 72 + seg * 8); }
        __syncthreads();
    }
}

__device__ __forceinline__ void scan_item(const Params& p, int l, int item, unsigned char* shm) {
    const int tid = ltid(), lane = tid & 63, wid = tid >> 6, fr = lane & 15, fq = lane >> 4, j = l >> 1;
    bf16_t* Ws = (bf16_t*)shm;
    bf16_t* Qs = Ws + 64 * 136;
    bf16_t* As = Qs + 64 * 136;
    bf16_t* Ks = As + 64 * 72;
    bf16_t* Us = Ks + 128 * 72;
    bf16_t* STs = Us + 64 * 40;
    bf16_t* VNs = STs + 32 * 136;
    int ty, seq, d, h, sl, chunk0, N, lat;
    if (item < 128) { lat = 1; ty = item >> 6; const int r = item & 63; seq = r >> 5; d = (r >> 4) & 1; h = (r >> 2) & 3; sl = r & 3; chunk0 = 64 + seq * 64; N = 64; }
    else { lat = 0; const int r0 = item - 128; ty = r0 >> 9; const int r = r0 & 511; seq = r >> 5; d = (r >> 4) & 1; h = (r >> 2) & 3; sl = r & 3; chunk0 = seq * 4; N = 4; }
    const int v0 = sl * 32;
    const unsigned char* pbase = ty == 0 ? p.ws + B_PREPD + (size_t)((d * 4 + h) * 192) * ITEM_D : p.ws + B_PREPR + (size_t)((d * 4 + h) * 192) * ITEM_R;
    const size_t istride = ty == 0 ? ITEM_D : ITEM_R;
    const float* GL = (const float*)(p.ws + OFF_GL) + ((ty * 2 + d) * 4 + h) * 192;
    bf16_t* ODIR = (bf16_t*)(p.ws + B_ODIR);
    f32x4 ST0, ST1;
    if (lat) { const float* s0 = p.in[ty == 0 ? I_SD : I_SR] + (size_t)((((seq * 2 + j) * 2 + d) * 4 + h)) * 16384;
        ST0 = *(const f32x4*)(s0 + (wid * 16 + fr) * 128 + v0 + fq * 4); ST1 = *(const f32x4*)(s0 + (wid * 16 + fr) * 128 + v0 + 16 + fq * 4); }
    else { ST0 = (f32x4){0.f, 0.f, 0.f, 0.f}; ST1 = ST0; }
    uint4 pw0, pw1, pq0, pq1, pk0, pk1, pa, pu;
    pw0 = pw1 = pu = make_uint4(0, 0, 0, 0);
#define SCAN_LOAD(cgx) do { const bf16_t* it_ = (const bf16_t*)(pbase + (size_t)(cgx) * istride); const int i0_ = tid, i1_ = tid + 512; \
        if (ty == 0) { pw0 = *(const uint4*)(it_ + PO_W + (i0_ >> 4) * 128 + (i0_ & 15) * 8); pw1 = *(const uint4*)(it_ + PO_W + (i1_ >> 4) * 128 + (i1_ & 15) * 8); } \
        pq0 = *(const uint4*)(it_ + PO_QD + (i0_ >> 4) * 128 + (i0_ & 15) * 8); pq1 = *(const uint4*)(it_ + PO_QD + (i1_ >> 4) * 128 + (i1_ & 15) * 8); \
        pk0 = *(const uint4*)(it_ + PO_KDT + i0_ * 8); pk1 = *(const uint4*)(it_ + PO_KDT + i1_ * 8); \
        pa = *(const uint4*)(it_ + PO_ATT + tid * 8); \
        if (tid < 256) pu = *(const uint4*)(it_ + PO_U + (tid >> 2) * 128 + v0 + (tid & 3) * 8); } while (0)
#define SCAN_STORE() do { const int i0_ = tid, i1_ = tid + 512; \
        if (ty == 0) { *(uint4*)(Ws + (i0_ >> 4) * 136 + (i0_ & 15) * 8) = pw0; *(uint4*)(Ws + (i1_ >> 4) * 136 + (i1_ & 15) * 8) = pw1; } \
        *(uint4*)(Qs + (i0_ >> 4) * 136 + (i0_ & 15) * 8) = pq0; *(uint4*)(Qs + (i1_ >> 4) * 136 + (i1_ & 15) * 8) = pq1; \
        *(uint4*)(Ks + (i0_ >> 3) * 72 + (i0_ & 7) * 8) = pk0; *(uint4*)(Ks + (i1_ >> 3) * 72 + (i1_ & 7) * 8) = pk1; \
        *(uint4*)(As + (tid >> 3) * 72 + (tid & 7) * 8) = pa; \
        if (tid < 256) *(uint4*)(Us + (tid >> 2) * 40 + (tid & 3) * 8) = pu; } while (0)
#define SCAN_ST_STORE() do { \
        STs[(fq * 4 + 0) * 136 + wid * 16 + fr] = f2bf(ST0[0]); STs[(fq * 4 + 1) * 136 + wid * 16 + fr] = f2bf(ST0[1]); STs[(fq * 4 + 2) * 136 + wid * 16 + fr] = f2bf(ST0[2]); STs[(fq * 4 + 3) * 136 + wid * 16 + fr] = f2bf(ST0[3]); \
        STs[(16 + fq * 4 + 0) * 136 + wid * 16 + fr] = f2bf(ST1[0]); STs[(16 + fq * 4 + 1) * 136 + wid * 16 + fr] = f2bf(ST1[1]); STs[(16 + fq * 4 + 2) * 136 + wid * 16 + fr] = f2bf(ST1[2]); STs[(16 + fq * 4 + 3) * 136 + wid * 16 + fr] = f2bf(ST1[3]); } while (0)
    SCAN_LOAD(chunk0 + (d ? N - 1 : 0));
    SCAN_STORE(); SCAN_ST_STORE();
    __syncthreads();
    const int tc = wid >> 1, tv = wid & 1;
    for (int n = 0; n < N; ++n) {
        const int cgi = chunk0 + (d ? N - 1 - n : n);
        if (n + 1 < N) SCAN_LOAD(chunk0 + (d ? N - 2 - n : n + 1));
        const float gl = GL[cgi];
        f32x4 aV = {0.f, 0.f, 0.f, 0.f}, aO = {0.f, 0.f, 0.f, 0.f};
#pragma unroll
        for (int k0 = 0; k0 < 128; k0 += 32) {
            const bf16x8 fb = *(const bf16x8*)(STs + (tv * 16 + fr) * 136 + k0 + fq * 8);
            const bf16x8 fqd = *(const bf16x8*)(Qs + (tc * 16 + fr) * 136 + k0 + fq * 8);
            aO = __builtin_amdgcn_mfma_f32_16x16x32_bf16(fqd, fb, aO, 0, 0, 0);
            if (ty == 0) { const bf16x8 fw = *(const bf16x8*)(Ws + (tc * 16 + fr) * 136 + k0 + fq * 8); aV = __builtin_amdgcn_mfma_f32_16x16x32_bf16(fw, fb, aV, 0, 0, 0); }
        }
        {   float vn[4];
#pragma unroll
            for (int jx = 0; jx < 4; ++jx) vn[jx] = bf2f(Us[(tc * 16 + fq * 4 + jx) * 40 + tv * 16 + fr]) - aV[jx];
            uint2 pk2; pk2.x = cvt_pk_bf16(vn[0], vn[1]); pk2.y = cvt_pk_bf16(vn[2], vn[3]);
            *(uint2*)(VNs + (tv * 16 + fr) * 72 + tc * 16 + fq * 4) = pk2; }
        __syncthreads();
#pragma unroll
        for (int k0 = 0; k0 < 64; k0 += 32) {
            const bf16x8 fa = *(const bf16x8*)(As + (tc * 16 + fr) * 72 + k0 + fq * 8);
            const bf16x8 fb = *(const bf16x8*)(VNs + (tv * 16 + fr) * 72 + k0 + fq * 8);
            aO = __builtin_amdgcn_mfma_f32_16x16x32_bf16(fa, fb, aO, 0, 0, 0);
        }
#pragma unroll
        for (int jx = 0; jx < 4; ++jx) { const int c = tc * 16 + fq * 4 + jx; const int tok = d ? cgi * 64 + 63 - c : cgi * 64 + c;
            ODIR[((size_t)d * NTOK + tok) * DM + ty * 512 + h * 128 + v0 + tv * 16 + fr] = f2bf(aO[jx]); }
        {   f32x4 a = ST0 * gl, b = ST1 * gl;
#pragma unroll
            for (int k0 = 0; k0 < 64; k0 += 32) {
                const bf16x8 fb = *(const bf16x8*)(Ks + (wid * 16 + fr) * 72 + k0 + fq * 8);
                const bf16x8 fa0 = *(const bf16x8*)(VNs + (fr) * 72 + k0 + fq * 8);
                const bf16x8 fa1 = *(const bf16x8*)(VNs + (16 + fr) * 72 + k0 + fq * 8);
                a = __builtin_amdgcn_mfma_f32_16x16x32_bf16(fa0, fb, a, 0, 0, 0);
                b = __builtin_amdgcn_mfma_f32_16x16x32_bf16(fa1, fb, b, 0, 0, 0);
            }
            ST0 = a; ST1 = b; }
        __syncthreads();
        SCAN_ST_STORE();
        if (n + 1 < N) SCAN_STORE();
        __syncthreads();
    }
    if (!lat) { float* o = p.out + (size_t)NTOK * DM + (ty ? 4194304 : 0) + (size_t)((((seq * 2 + j) * 2 + d) * 4 + h)) * 16384;
        *(f32x4*)(o + (wid * 16 + fr) * 128 + v0 + fq * 4) = ST0; *(f32x4*)(o + (wid * 16 + fr) * 128 + v0 + 16 + fq * 4) = ST1; }
#undef SCAN_LOAD
#undef SCAN_STORE
#undef SCAN_ST_STORE
}
__device__ __forceinline__ void phase_scan(const Params& p, int l, unsigned char* shm) {
    const int G = (int)gridDim.x, b = lbid();
    if (G >= 256) {
        if (b < 128) scan_item(p, l, b, shm);
        else for (int it = 128 + (b - 128); it < 1152; it += G - 128) scan_item(p, l, it, shm);
    } else for (int it = b; it < 1152; it += G) scan_item(p, l, it, shm);
}

__device__ __forceinline__ void phase_post(const Params& p, int l, unsigned char* shm) {
    const int tid = ltid(), lane = tid & 63, wid = tid >> 6, j = l >> 1;
    const bf16_t* O0 = (const bf16_t*)(p.ws + B_ODIR); const bf16_t* O1 = O0 + (size_t)NTOK * DM; const bf16_t* ZG = (const bf16_t*)(p.ws + B_ZG);
    bf16_t* H = (bf16_t*)(p.ws + OFF_H);
    const int g = lane >> 3, e0 = (lane & 7) * 16;
    const float* nrm = (g < 4 ? p.in[I_NA] : p.in[I_NB]) + j * 128 + e0;
    for (int row = lbid() * 8 + wid; row < NTOK; row += (int)gridDim.x * 8) {
        const size_t off = (size_t)row * DM + g * 128 + e0;
        float a[16], b[16], z[16];
        { const uint4* pa = (const uint4*)(O0 + off); unpack8(pa[0], a); unpack8(pa[1], a + 8); const uint4* pb = (const uint4*)(O1 + off); unpack8(pb[0], b); unpack8(pb[1], b + 8);
          const uint4* pz = (const uint4*)(ZG + off); unpack8(pz[0], z); unpack8(pz[1], z + 8); }
        float s = 0.f;
#pragma unroll
        for (int e = 0; e < 16; ++e) { a[e] += b[e]; s += a[e]; }
        float mu = 0.f;
        if (g >= 4) { s += __shfl_xor(s, 1); s += __shfl_xor(s, 2); s += __shfl_xor(s, 4); mu = s * (1.0f / 128.0f); }
        float q = 0.f;
#pragma unroll
        for (int e = 0; e < 16; ++e) { a[e] -= mu; q += a[e] * a[e]; }
        q += __shfl_xor(q, 1); q += __shfl_xor(q, 2); q += __shfl_xor(q, 4);
        const float r = rsqrtf(q * (1.0f / 128.0f) + 1e-6f);
#pragma unroll
        for (int e = 0; e < 16; ++e) a[e] = a[e] * r * nrm[e] * silu(z[e]);
        *(uint4*)(H + off) = pack8(a); *(uint4*)(H + off + 8) = pack8(a + 8);
    }
}

__device__ __forceinline__ void phase_hyena_pre(const Params& p, int l, unsigned char* shm) {
    const int tid = ltid(), j = l >> 1, G = (int)gridDim.x;
    const float* HID2 = (const float*)(p.ws + OFF_HID2);
    const float* w3 = p.in[I_FW3] + (size_t)j * 64 * 2048; const float* fbias = p.in[I_FBIAS] + j * 1024;
    {   float* hs = (float*)shm;
        float* w3s = hs + 64 * 65;
        for (int it = lbid(); it < 1088; it += G) {
            const int big = it < 1024; const int L = big ? 4096 : 256; const int r = big ? it : it - 1024; const int pt = r >> 4, ct = r & 15;
            const int i0 = pt * 64, c0 = ct * 64; const float* hsrc = HID2 + (size_t)((big ? 0 : 4096) + i0) * 64;
            float* kern = (float*)(p.ws + (big ? B_KERN : B_KERN256));
#pragma unroll
            for (int i = 0; i < 8; ++i) { const int idx = tid + i * 512; hs[(idx >> 6) * 65 + (idx & 63)] = hsrc[idx]; }
#pragma unroll
            for (int i = 0; i < 16; ++i) { const int idx = tid + i * 512; const int k = idx >> 7, cc = idx & 127; w3s[idx] = w3[(size_t)k * 2048 + (cc < 64 ? c0 + cc : 1024 + c0 + cc - 64)]; }
            __syncthreads();
            const int pp = tid & 63, cgp = tid >> 6;
            float af[8], ab[8];
#pragma unroll
            for (int e = 0; e < 8; ++e) { af[e] = 0.f; ab[e] = 0.f; }
#pragma unroll 4
            for (int k = 0; k < 64; ++k) { const float hv = hs[pp * 65 + k];
#pragma unroll
                for (int e = 0; e < 8; ++e) { af[e] += hv * w3s[k * 128 + cgp * 8 + e]; ab[e] += hv * w3s[k * 128 + 64 + cgp * 8 + e]; } }
            const int i = i0 + pp; const float tt = (float)i / (float)(L - 1);
#pragma unroll
            for (int e = 0; e < 8; ++e) { const int c = c0 + cgp * 8 + e;
                const float dl = fabsf(-3.0701134573253943f + (float)c * ((-15.350567286626972f + 3.0701134573253943f) / 1023.0f));
                const float win = __expf(-tt * dl);
                float* kc = kern + (size_t)c * (2 * L);
                kc[i] = af[e] * win + (i == 0 ? fbias[c] : 0.f);
                if (i == 0) kc[L] = 0.f; else kc[2 * L - i] = ab[e] * win; }
            __syncthreads();
        }
    }
    {   float* tile = (float*)shm;
        const bf16_t* U = (const bf16_t*)(p.ws + B_U); float* VXT = (float*)(p.ws + B_VXT);
        const float* cw = p.in[I_HYCW] + (size_t)j * 3 * 3072; const float* cb = p.in[I_HYCB] + j * 3072;
        for (int it = lbid(); it < 3072; it += G) {
            const int tt0 = (it >> 4) * 64, c0 = (it & 15) * 64; int sbase, L; tokinfo(tt0, sbase, L);
            const int ch = tid & 63, tg = tid >> 6, c = c0 + ch;
            float res[8];
#pragma unroll
            for (int e = 0; e < 8; ++e) res[e] = 1.f;
#pragma unroll
            for (int part = 1; part < 3; ++part) { const int col = part * 1024 + c;
                const float w0 = cw[col], w1 = cw[3072 + col], w2 = cw[6144 + col], bb = cb[col];
                float x[10];
#pragma unroll
                for (int e = 0; e < 10; ++e) { const int t = tt0 + tg * 8 + e - 1; x[e] = (t >= sbase && t < sbase + L) ? bf2f(U[(size_t)t * 3072 + col]) : 0.f; }
#pragma unroll
                for (int e = 0; e < 8; ++e) res[e] *= (x[e] * w0 + x[e + 1] * w1 + x[e + 2] * w2 + bb); }
#pragma unroll
            for (int e = 0; e < 8; ++e) tile[ch * 65 + tg * 8 + e] = res[e];
            __syncthreads();
            {   const int r = tid >> 3, e0 = (tid & 7) * 8;
                float* dst = VXT + (size_t)sbase * DM + (size_t)(c0 + r) * L + (tt0 - sbase) + e0;
                float4 o0, o1; o0.x = tile[r * 65 + e0]; o0.y = tile[r * 65 + e0 + 1]; o0.z = tile[r * 65 + e0 + 2]; o0.w = tile[r * 65 + e0 + 3];
                o1.x = tile[r * 65 + e0 + 4]; o1.y = tile[r * 65 + e0 + 5]; o1.z = tile[r * 65 + e0 + 6]; o1.w = tile[r * 65 + e0 + 7];
                *(float4*)dst = o0; *(float4*)(dst + 4) = o1; }
            __syncthreads();
        }
    }
}

__device__ __forceinline__ void fft_fwd(float2* X, int lgN, int nbf) {
    const int lgh = lgN - 1;
    for (int s = lgh; s >= 0; --s) {
        const int m = 1 << s; const float inv2m = 1.0f / (float)(2 * m);
        for (int b = ltid(); b < nbf; b += 512) {
            const int bt = b >> lgh, lb = b & ((1 << lgh) - 1), pos = lb & (m - 1), grp = lb >> s;
            const int i = (bt << lgN) + (grp << (s + 1)) + pos, jx = i + m;
            const float2 a = X[i], c = X[jx];
            const float fr = (float)pos * inv2m; const float cs = __builtin_amdgcn_cosf(fr), sn = __builtin_amdgcn_sinf(fr);
            const float dx = a.x - c.x, dy = a.y - c.y;
            X[i] = make_float2(a.x + c.x, a.y + c.y);
            X[jx] = make_float2(dx * cs + dy * sn, dy * cs - dx * sn);
        }
        __syncthreads();
    }
}
__device__ __forceinline__ void fft_inv(float2* X, int lgN, int nbf) {
    const int lgh = lgN - 1;
    for (int s = 0; s <= lgh; ++s) {
        const int m = 1 << s; const float inv2m = 1.0f / (float)(2 * m);
        for (int b = ltid(); b < nbf; b += 512) {
            const int bt = b >> lgh, lb = b & ((1 << lgh) - 1), pos = lb & (m - 1), grp = lb >> s;
            const int i = (bt << lgN) + (grp << (s + 1)) + pos, jx = i + m;
            const float2 a = X[i], c = X[jx];
            const float fr = (float)pos * inv2m; const float cs = __builtin_amdgcn_cosf(fr), sn = __builtin_amdgcn_sinf(fr);
            const float tx = c.x * cs - c.y * sn, ty = c.x * sn + c.y * cs;
            X[i] = make_float2(a.x + tx, a.y + ty);
            X[jx] = make_float2(a.x - tx, a.y - ty);
        }
        __syncthreads();
    }
}
__device__ __forceinline__ void phase_hyena_fft(const Params& p, int l, unsigned char* shm) {
    const int tid = ltid(), G = (int)gridDim.x;
    float2* A = (float2*)shm; float2* B = A + 8192;
    float* VXT = (float*)(p.ws + B_VXT);
    for (int it = lbid(); it < 2048; it += G) {
        if (it < 1024) {
            const int c = it; const float* kern = (const float*)(p.ws + B_KERN) + (size_t)c * 8192;
            float* y0 = VXT + (size_t)NCTX * DM + (size_t)c * 4096; float* y1 = y0 + (size_t)4096 * DM;
            for (int m = tid; m < 8192; m += 512) { A[m] = make_float2(kern[m], 0.f); B[m] = m < 4096 ? make_float2(y0[m], y1[m]) : make_float2(0.f, 0.f); }
            __syncthreads();
            fft_fwd(A, 13, 4096); fft_fwd(B, 13, 4096);
            for (int m = tid; m < 8192; m += 512) { const float2 a = A[m], b = B[m]; B[m] = make_float2(a.x * b.x - a.y * b.y, a.x * b.y + a.y * b.x); }
            __syncthreads();
            fft_inv(B, 13, 4096);
            for (int m = tid; m < 4096; m += 512) { const float2 b = B[m]; y0[m] = b.x * (1.0f / 8192.0f); y1[m] = b.y * (1.0f / 8192.0f); }
            __syncthreads();
        } else {
            const int c = it - 1024; const float* kern = (const float*)(p.ws + B_KERN256) + (size_t)c * 512;
            A[tid] = make_float2(kern[tid], 0.f);
            for (int m = tid; m < 4096; m += 512) { const int pr = m >> 9, q = m & 511;
                const float* ya = VXT + (size_t)(2 * pr) * 256 * DM + (size_t)c * 256; const float* yb = ya + (size_t)256 * DM;
                B[m] = q < 256 ? make_float2(ya[q], yb[q]) : make_float2(0.f, 0.f); }
            __syncthreads();
            fft_fwd(A, 9, 256); fft_fwd(B, 9, 2048);
            for (int m = tid; m < 4096; m += 512) { const float2 a = A[m & 511], b = B[m]; B[m] = make_float2(a.x * b.x - a.y * b.y, a.x * b.y + a.y * b.x); }
            __syncthreads();
            fft_inv(B, 9, 2048);
            for (int m = tid; m < 4096; m += 512) { const int pr = m >> 9, q = m & 511;
                if (q < 256) { float* ya = VXT + (size_t)(2 * pr) * 256 * DM + (size_t)c * 256; float* yb = ya + (size_t)256 * DM; const float2 b = B[m]; ya[q] = b.x * (1.0f / 512.0f); yb[q] = b.y * (1.0f / 512.0f); } }
            __syncthreads();
        }
    }
}
__device__ __forceinline__ void phase_hyena_post(const Params& p, int l, unsigned char* shm) {
    const int tid = ltid(), j = l >> 1, G = (int)gridDim.x;
    float* tile = (float*)shm;
    const bf16_t* U = (const bf16_t*)(p.ws + B_U); const float* VXT = (const float*)(p.ws + B_VXT); bf16_t* H = (bf16_t*)(p.ws + OFF_H);
    const float* cw = p.in[I_HYCW] + (size_t)j * 3 * 3072; const float* cb = p.in[I_HYCB] + j * 3072;
    for (int it = lbid(); it < 3072; it += G) {
        const int tt0 = (it >> 4) * 64, c0 = (it & 15) * 64; int sbase, L; tokinfo(tt0, sbase, L);
        {   const int r = tid >> 3, e0 = (tid & 7) * 8;
            const float* src = VXT + (size_t)sbase * DM + (size_t)(c0 + r) * L + (tt0 - sbase) + e0;
            const float4 o0 = *(const float4*)src, o1 = *(const float4*)(src + 4);
            tile[r * 65 + e0] = o0.x; tile[r * 65 + e0 + 1] = o0.y; tile[r * 65 + e0 + 2] = o0.z; tile[r * 65 + e0 + 3] = o0.w;
            tile[r * 65 + e0 + 4] = o1.x; tile[r * 65 + e0 + 5] = o1.y; tile[r * 65 + e0 + 6] = o1.z; tile[r * 65 + e0 + 7] = o1.w; }
        __syncthreads();
        const int ch = tid & 63, tg = tid >> 6, c = c0 + ch;
        const float w0 = cw[c], w1 = cw[3072 + c], w2 = cw[6144 + c], bb = cb[c];
        float x[10];
#pragma unroll
        for (int e = 0; e < 10; ++e) { const int t = tt0 + tg * 8 + e - 1; x[e] = (t >= sbase && t < sbase + L) ? bf2f(U[(size_t)t * 3072 + c]) : 0.f; }
#pragma unroll
        for (int e = 0; e < 8; ++e) { const float x0 = x[e] * w0 + x[e + 1] * w1 + x[e + 2] * w2 + bb;
            H[(size_t)(tt0 + tg * 8 + e) * DM + c] = f2bf(x0 * tile[ch * 65 + tg * 8 + e]); }
        __syncthreads();
    }
}

__device__ __forceinline__ void phase_ffn_act(const Params& p, int l, unsigned char* shm) {
    const bf16_t* GU = (const bf16_t*)(p.ws + B_GU); bf16_t* ACT = (bf16_t*)(p.ws + B_ACT);
    const int T = (int)gridDim.x * 512, gt = lbid() * 512 + ltid(), nrows = T / 352;
    const int fg = gt % 352, trow = gt / 352, f0 = fg * 8;
    if (trow >= nrows) return;
    const float* cwp = p.in[I_FCONV] + (size_t)l * 9 * 2816 + f0;
    float w[9][8], bias[8];
#pragma unroll
    for (int i = 0; i < 9; ++i) { const float4 a = *(const float4*)(cwp + i * 2816), b = *(const float4*)(cwp + i * 2816 + 4);
        w[i][0] = a.x; w[i][1] = a.y; w[i][2] = a.z; w[i][3] = a.w; w[i][4] = b.x; w[i][5] = b.y; w[i][6] = b.z; w[i][7] = b.w; }
    { const float4 a = *(const float4*)(p.in[I_FCB] + l * 2816 + f0), b = *(const float4*)(p.in[I_FCB] + l * 2816 + f0 + 4);
      bias[0] = a.x; bias[1] = a.y; bias[2] = a.z; bias[3] = a.w; bias[4] = b.x; bias[5] = b.y; bias[6] = b.z; bias[7] = b.w; }
    for (int t = trow; t < NTOK; t += nrows) {
        float acc[8];
#pragma unroll
        for (int e = 0; e < 8; ++e) acc[e] = bias[e];
        if (t < NCTX) {
            const int pos = t & 255;
#pragma unroll
            for (int jx = 0; jx < 3; ++jx) { const int pp = pos + jx - 1;
                if (pp >= 0 && pp < 256) { float x[8]; unpack8(*(const uint4*)(GU + (size_t)(t + jx - 1) * 5632 + f0), x);
#pragma unroll
                    for (int e = 0; e < 8; ++e) acc[e] += x[e] * w[3 + jx][e]; } }
        } else {
            const int pos = (t - NCTX) & 4095, sb = t - pos, row = pos >> 6, cl = pos & 63;
#pragma unroll
            for (int i = 0; i < 3; ++i)
#pragma unroll
                for (int jx = 0; jx < 3; ++jx) { const int rr = row + i - 1, cc = cl + jx - 1;
                    if (rr >= 0 && rr < 64 && cc >= 0 && cc < 64) { float x[8]; unpack8(*(const uint4*)(GU + (size_t)(sb + rr * 64 + cc) * 5632 + f0), x);
#pragma unroll
                        for (int e = 0; e < 8; ++e) acc[e] += x[e] * w[i * 3 + jx][e]; } }
        }
        float up[8]; unpack8(*(const uint4*)(GU + (size_t)t * 5632 + 2816 + f0), up);
#pragma unroll
        for (int e = 0; e < 8; ++e) acc[e] = silu(acc[e]) * up[e];
        *(uint4*)(ACT + (size_t)t * 2816 + f0) = pack8(acc);
    }
}

constexpr int NPHASE = 42;
#ifndef ONLY
#define ONLY -1
#endif
#define ON(id) (ONLY < 0 || ONLY == (id))
__device__ __forceinline__ void run_phase(const Params& p, int ph, unsigned char* shm) {
    if (ph == 0) { if (ON(0)) phase_prologue(p, shm); return; }
    if (ph == NPHASE - 1) { if (ON(1)) norm_rows(p, 0, 2, shm); return; }
    const int l = (ph - 1) / 10, s = (ph - 1) % 10; const bool even = (l & 1) == 0; const int j = l >> 1;
    const float* MOD = (const float*)(p.ws + OFF_MOD);
    bf16_t* H = (bf16_t*)(p.ws + OFF_H);
    switch (s) {
    case 0: if (ON(2)) norm_rows(p, l, 0, shm); __syncthreads(); if (ON(2)) { if (!even) hyena_hid2(p, l, shm); convert_ffn(p, l, shm); } break;
    case 1: if (even && ON(3)) { EpiBf16S E; E.O1 = (bf16_t*)(p.ws + B_QKV); E.ld1 = 3072; E.nsplit = 12; E.O2 = (bf16_t*)(p.ws + B_ZG); E.ld2 = 1024; E.bias = nullptr;
                run_gemm(shm, H, (const bf16_t*)(p.ws + OFF_WIN), 4096, 1024, E); }
            else if (!even && ON(4)) { EpiBf16S E; E.O1 = (bf16_t*)(p.ws + B_U); E.ld1 = 3072; E.nsplit = 1000; E.O2 = nullptr; E.ld2 = 0; E.bias = p.in[I_HYBIN] + j * 3072;
                run_gemm(shm, H, (const bf16_t*)(p.ws + OFF_WIN), 3072, 1024, E); }
            break;
    case 2: if (even) { if (ON(5)) phase_prep(p, l, shm); } else if (ON(6)) phase_hyena_pre(p, l, shm); break;
    case 3: if (even) { if (ON(7)) phase_scan(p, l, shm); } else if (ON(8)) phase_hyena_fft(p, l, shm); break;
    case 4: if (even) { if (ON(9)) phase_post(p, l, shm); } else if (ON(10)) phase_hyena_post(p, l, shm); break;
    case 5: if (ON(11)) { EpiRes E; E.X = p.out; E.gate = MOD + (l * 3) * 6144 + 2048; E.bias = even ? nullptr : p.in[I_HYBOUT] + j * 1024;
              run_gemm(shm, H, (const bf16_t*)(p.ws + OFF_WOUT), 1024, 1024, E); } break;
    case 6: if (ON(12)) { norm_rows(p, l, 1, shm); __syncthreads(); if (l < 3) convert_mixer(p, l + 1, shm); } break;
    case 7: if (ON(13)) { EpiBf16S E; E.O1 = (bf16_t*)(p.ws + B_GU); E.ld1 = 5632; E.nsplit = 1000; E.O2 = nullptr; E.ld2 = 0; E.bias = nullptr;
              run_gemm(shm, H, (const bf16_t*)(p.ws + OFF_WGU), 5632, 1024, E); } break;
    case 8: if (ON(14)) phase_ffn_act(p, l, shm); break;
    case 9: if (ON(15)) { EpiRes E; E.X = p.out; E.gate = MOD + (l * 3) * 6144 + 5120; E.bias = nullptr;
              run_gemm(shm, (const bf16_t*)(p.ws + B_ACT), (const bf16_t*)(p.ws + OFF_WDN), 1024, 2816, E); } break;
    }
}

typedef const __attribute__((address_space(4))) Params* KP;
__global__ void __launch_bounds__(512, 2) mk_fwd(Params p) {
    extern __shared__ __attribute__((aligned(16))) unsigned char shm[];
    cg::grid_group grid = cg::this_grid();
    KP kp0 = (KP)__builtin_amdgcn_kernarg_segment_ptr();
    const int lo = p.lo, hi = p.hi;
    for (int ph = lo; ph < hi; ++ph) {
        KP kp = kp0; asm volatile("" : "+s"(kp));
        run_phase(*(const Params*)kp, ph, shm);
        if (ph + 1 < hi) grid.sync();
    }
}

#ifndef MK_ONE_LAUNCH
#define MK_ONE_LAUNCH 0
#endif

extern "C" void kernel_launch(void* const* d_in, const int* in_sizes, int n_in, void* d_out, int out_size, void* d_ws, size_t ws_size, hipStream_t stream) {
    static int grid = 0;
    if (grid == 0) {
        if (n_in != N_IN || ws_size < WS_NEED) { fprintf(stderr, "kernel_launch: unexpected n_in %d or ws_size %zu (need %zu)\n", n_in, ws_size, (size_t)WS_NEED); grid = -1; return; }
        int dev = 0, cus = 0, per_cu = 0;
        hipGetDevice(&dev); hipDeviceGetAttribute(&cus, hipDeviceAttributeMultiprocessorCount, dev);
        if (hipFuncSetAttribute((const void*)mk_fwd, hipFuncAttributeMaxDynamicSharedMemorySize, LDS_BYTES) != hipSuccess) { fprintf(stderr, "kernel_launch: hipFuncSetAttribute failed\n"); grid = -1; return; }
        if (hipOccupancyMaxActiveBlocksPerMultiprocessor(&per_cu, (const void*)mk_fwd, 512, LDS_BYTES) != hipSuccess || per_cu < 1) { fprintf(stderr, "kernel_launch: occupancy query failed (%d)\n", per_cu); (void)hipGetLastError(); per_cu = 1; }
        grid = cus * 1;
        if (grid <= 0) grid = 256;
    }
    if (grid < 0) return;
    Params p{};
    for (int i = 0; i < N_IN; ++i) p.in[i] = (const float*)d_in[i];
    p.out = (float*)d_out; p.ws = (unsigned char*)d_ws;
#if MK_ONE_LAUNCH
    p.lo = 0; p.hi = NPHASE;
    void* args[] = {&p};
    hipError_t e = hipLaunchCooperativeKernel((const void*)mk_fwd, dim3(grid), dim3(512), args, LDS_BYTES, stream);
    if (e != hipSuccess) fprintf(stderr, "cooperative launch failed: %s (grid %d)\n", hipGetErrorString(e), grid);
#else
#ifndef PROBE_NPH
#define PROBE_NPH NPHASE
#endif
    for (int ph = 0; ph < NPHASE; ++ph) { if (ph >= PROBE_NPH && ph != NPHASE - 1) continue; p.lo = ph; p.hi = ph + 1; hipLaunchKernelGGL(mk_fwd, dim3(grid), dim3(512), LDS_BYTES, stream, p); }
#endif
}
```

```cpp
#include <hip/hip_runtime.h>
#include <hip/hip_cooperative_groups.h>
#include <cstdio>
namespace cg = cooperative_groups;
__device__ __forceinline__ int ltid() { int t = threadIdx.x; asm volatile("" : "+v"(t)); return t; }
__device__ __forceinline__ int lbid() { int t = blockIdx.x; asm volatile("" : "+s"(t)); return t; }
#define LAS __attribute__((address_space(3)))
#define XB_TMO      128
#define XB_XCNT(j)  (256  + 64 * (j))
#define XB_XSUB(j)  (1280 + 64 * (j))
#define XB_XGEN(j)  (2304 + 64 * (j))
#define XB_TOP      3328
#define XB_TOPGEN   3392
#define XCD_BAR_WORDS 3456
#define XB_SPIN_CAP (1u << 18)
__device__ __forceinline__ unsigned xb_ld(unsigned* p)              { return __hip_atomic_load(p, __ATOMIC_RELAXED, __HIP_MEMORY_SCOPE_AGENT); }
__device__ __forceinline__ unsigned xb_add(unsigned* p, unsigned v) { return __hip_atomic_fetch_add(p, v, __ATOMIC_RELAXED, __HIP_MEMORY_SCOPE_AGENT); }
__device__ __forceinline__ unsigned xb_xcc_id() { return (unsigned)__builtin_amdgcn_s_getreg((3 << 11) | 20) & 0xFu; }
#define XB_SPIN(cond, bar) do { unsigned _sp = 0; while (cond) { __builtin_amdgcn_s_sleep(1); \
    if ((++_sp & 255u) == 0u) { if (xb_ld(&(bar)[XB_TMO])) break; if (_sp > XB_SPIN_CAP) { atomicAdd(&(bar)[XB_TMO], 1u); break; } } } } while (0)

struct XcdBarrier {
    unsigned* bar; unsigned x;
    volatile LAS unsigned* st;
};

__device__ __forceinline__ XcdBarrier xcd_barrier_post(unsigned* bar, volatile LAS unsigned* st) {
    XcdBarrier b; b.bar = bar; b.x = xb_xcc_id(); b.st = st;
    if (threadIdx.x == 0) (void)xb_add(&bar[XB_XCNT(b.x)], 1u);
    return b;
}
__device__ __forceinline__ void xcd_barrier_complete(unsigned* bar, unsigned x, unsigned& nloc, unsigned& nx) {
    const unsigned G = gridDim.x * gridDim.y * gridDim.z;
    unsigned sum, cnt, mine, sp = 0u;
    for (;;) {
        sum = 0u; cnt = 0u; mine = 0u;
#pragma unroll
        for (unsigned j = 0; j < 16; ++j) { const unsigned c = xb_ld(&bar[XB_XCNT(j)]); sum += c; cnt += (c > 0u) ? 1u : 0u; mine = (j == x) ? c : mine; }
        if (sum == G) break;
        __builtin_amdgcn_s_sleep(1);
        if ((++sp & 255u) == 0u) { if (xb_ld(&bar[XB_TMO])) break; if (sp > XB_SPIN_CAP) { atomicAdd(&bar[XB_TMO], 1u); break; } }
    }
    nloc = mine > 0u ? mine : 1u; nx = cnt > 0u ? cnt : 1u;
}

__device__ __forceinline__ void xcd_barrier(const XcdBarrier& b) {
    asm volatile("s_waitcnt vmcnt(0)" ::: "memory");
    __syncthreads();
    if (threadIdx.x == 0) {
        unsigned* bar = b.bar;
        __builtin_amdgcn_s_waitcnt(0);
        unsigned nloc = b.st[0], nx = b.st[1];
        if (nloc == 0u) { xcd_barrier_complete(bar, b.x, nloc, nx); b.st[0] = nloc; b.st[1] = nx; }
        const unsigned old = xb_add(&bar[XB_XSUB(b.x)], 1u);
        const unsigned gen = old / nloc;
        if (old + 1u == (gen + 1u) * nloc) {
            __builtin_amdgcn_fence(__ATOMIC_RELEASE, "agent");
            asm volatile("s_waitcnt vmcnt(0)" ::: "memory");
            const unsigned og = xb_add(&bar[XB_TOP], 1u);
            const unsigned tg = og / nx;
            if (og + 1u == (tg + 1u) * nx) xb_add(&bar[XB_TOPGEN], 1u);
            else XB_SPIN(xb_ld(&bar[XB_TOPGEN]) == tg, bar);
            __builtin_amdgcn_fence(__ATOMIC_ACQUIRE, "agent");
            xb_add(&bar[XB_XGEN(b.x)], 1u);
            asm volatile("s_waitcnt vmcnt(0)" ::: "memory");
        } else {
            XB_SPIN(xb_ld(&bar[XB_XGEN(b.x)]) == gen, bar);
            __builtin_amdgcn_fence(__ATOMIC_ACQUIRE, "agent");
            asm volatile("s_waitcnt vmcnt(0)" ::: "memory");
        }
    }
    __syncthreads();
}

#define XB_REC_WORDS 32
namespace pg8 {
#define PG8_LAS __attribute__((address_space(3)))
typedef unsigned short bf16_t;
typedef short bf16x8 __attribute__((ext_vector_type(8)));
typedef float f32x4 __attribute__((ext_vector_type(4)));
typedef unsigned u32x4 __attribute__((ext_vector_type(4)));
constexpr int BM = 256, BK = 64, HALF = 128, HTB = HALF * BK * 2  , STAGE_BYTES = 8 * HTB, NXCD = 8, WGM = 8;

__host__ __device__ __forceinline__ int lds_byte(int r, int c) { const int st = (r >> 4) * 2 + (c >> 5), rr = r & 15, cc = c & 31, ob = rr * 64 + cc * 2; return st * 1024 + (ob ^ (((ob >> 9) & 1) << 5)); }
__host__ __device__ __forceinline__ void stage_rc(int b, int& R, int& C) { const int st = b / 1024, sb = b % 1024, swz = sb ^ (((sb >> 9) & 1) << 5); R = (st >> 1) * 16 + swz / 64; C = (st & 1) * 32 + (swz % 64) / 2; }
__host__ __device__ __forceinline__ int perm32(int rho) { const int n = rho >> 4, i = rho & 15; return 8 * (i >> 2) + 4 * n + (i & 3); }

struct Unit { int pm, pn; };
struct Gemm { const bf16_t* A; const bf16_t* Bt; int M, N, K; };

struct StaticOrder {
    int nM, nN, nwg, G, c;
    __host__ __device__ void init(int M, int N, int G_, int c_) { nM = M / BM; nN = N / BM; nwg = nM * nN; G = G_; c = c_; }
    __host__ __device__ bool next(int i, Unit& u) const {
        const long L = (long)i * G + c; if (L >= nwg) return false;
        int wgid = (int)L; { const int q = nwg / NXCD, r = nwg % NXCD, xcd = wgid % NXCD, off = wgid / NXCD; wgid = (xcd < r ? xcd * (q + 1) : r * (q + 1) + (xcd - r) * q) + off; }
        const int nig = WGM * nN, gid = wgid / nig, fm = gid * WGM, gsz = (nM - fm) < WGM ? (nM - fm) : WGM;
        u.pm = fm + ((wgid % nig) % gsz); u.pn = (wgid % nig) / gsz; return true;
    }
    __device__ __forceinline__ void a_ready(const Unit&) const {}
    __device__ __forceinline__ void done(const Unit&) const {}
};
__device__ __forceinline__ unsigned cvt_pk_bf16(float lo, float hi) {
    typedef __bf16 bf2_t __attribute__((ext_vector_type(2))); typedef float f2_t __attribute__((ext_vector_type(2)));
    f2_t v = {lo, hi}; bf2_t r = __builtin_convertvector(v, bf2_t); return __builtin_bit_cast(unsigned, r); }
typedef float f32x2 __attribute__((ext_vector_type(2)));
template <class Epi, class Sched, bool STAMP = false>
__device__ __forceinline__ void gemm_phase(PG8_LAS unsigned char* lds, const Gemm g, const Sched& S, const Epi& E, unsigned long long* stamps) {
    const int tid = ltid(), wid = __builtin_amdgcn_readfirstlane(tid >> 6), lane = tid & 63, wr = wid >> 2, wc = wid & 3, fr = lane & 15, fq = lane >> 4;
    const int K = g.K, nt = K / BK;
    int ts_lo = 0, ts_hi = 0, nts = 0; const unsigned long long rt_entry = STAMP ? (unsigned long long)wall_clock64() : 0ull;
#define PG8_STAMP() do { if (STAMP && wid == 0 && nts < 64) { const unsigned long long _c = (unsigned long long)clock64(); \
        ts_lo = (lane == nts) ? (int)(unsigned)_c : ts_lo; ts_hi = (lane == nts) ? (int)(unsigned)(_c >> 32) : ts_hi; ++nts; } } while (0)
    PG8_STAMP();
    unsigned voffA[2], voffB[2];
#pragma unroll
    for (int i = 0; i < 2; ++i) { int R, C; stage_rc(tid * 16 + i * 8192, R, C); const int Rb = Epi::PERM ? ((R & ~31) + perm32(R & 31)) : R;
        voffA[i] = (unsigned)(R * K + C) * 2u; voffB[i] = (unsigned)(Rb * K + C) * 2u; }
    const size_t kstep = (size_t)(BK * 2);
    const size_t hstep = (size_t)HALF * K * 2;
    const size_t tstep = 2 * hstep;
    const unsigned ldsw = (unsigned)wid * 1024u;
    const int aoff = lds_byte(wr * 64 + fr, fq * 8), boff = lds_byte(wc * 32 + fr, fq * 8);
#define PG8_SA(b, h) (((b) * 2 + (h)) * HTB)
#define PG8_SB(b, h) ((4 + (b) * 2 + (h)) * HTB)
#define PG8_STAGE(bufoff, gbase, voff) do { _Pragma("unroll") for (int _i = 0; _i < 2; ++_i) \
        __builtin_amdgcn_global_load_lds((const unsigned*)((const char*)(gbase) + (voff)[_i]), (PG8_LAS unsigned*)(lds + (bufoff) + ldsw + _i * 8192), 16, 0, 0); } while (0)
#define PG8_LDA(dst, b, h) do { _Pragma("unroll") for (int m = 0; m < 4; ++m) _Pragma("unroll") for (int k = 0; k < 2; ++k) dst[m][k] = *(const PG8_LAS bf16x8*)(lds + PG8_SA(b, h) + aoff + m * 2048 + k * 1024); } while (0)
#define PG8_LDB(dst, b, h) do { _Pragma("unroll") for (int n = 0; n < 2; ++n) _Pragma("unroll") for (int k = 0; k < 2; ++k) dst[n][k] = *(const PG8_LAS bf16x8*)(lds + PG8_SB(b, h) + boff + n * 2048 + k * 1024); } while (0)
#define PG8_MMA(ai, bj, At, Bt) do { __builtin_amdgcn_s_setprio(1); _Pragma("unroll") for (int m = 0; m < 4; ++m) _Pragma("unroll") for (int n = 0; n < 2; ++n) _Pragma("unroll") for (int k = 0; k < 2; ++k) \
        acc[ai][bj][m][n] = __builtin_amdgcn_mfma_f32_16x16x32_bf16(Bt[n][k], At[m][k], acc[ai][bj][m][n], 0, 0, 0); __builtin_amdgcn_s_setprio(0); } while (0)
#define PG8_WAIT_V(n) asm volatile("s_waitcnt vmcnt(" #n ")" ::: "memory")
#define PG8_WAIT_L(n) asm volatile("s_waitcnt lgkmcnt(" #n ")" ::: "memory")
#define PG8_BAR __builtin_amdgcn_s_barrier()
#define PG8_SCHED __builtin_amdgcn_sched_barrier(0)
    Unit cur, nxt; int ui = 0;
    if (!S.next(0, cur)) return;
    f32x4 acc[2][2][4][2];
#pragma unroll
    for (int a = 0; a < 2; ++a)
#pragma unroll
        for (int b = 0; b < 2; ++b)
#pragma unroll
            for (int m = 0; m < 4; ++m)
#pragma unroll
                for (int n = 0; n < 2; ++n) acc[a][b][m][n] = (f32x4){0.f, 0.f, 0.f, 0.f};
    bf16x8 At[4][2], B0[2][2], B1[2][2];
    const char* cA = (const char*)g.A + (size_t)cur.pm * tstep; const char* cB = (const char*)g.Bt + (size_t)cur.pn * tstep;
    S.a_ready(cur);
    PG8_STAGE(PG8_SB(0, 0), cB, voffB); PG8_STAGE(PG8_SA(0, 0), cA, voffA); PG8_STAGE(PG8_SB(0, 1), cB + hstep, voffB); PG8_STAGE(PG8_SA(0, 1), cA + hstep, voffA);
    if (wr == 1) PG8_BAR;
    PG8_WAIT_V(4); PG8_BAR;
    PG8_STAGE(PG8_SB(1, 0), cB + kstep, voffB); PG8_STAGE(PG8_SA(1, 0), cA + kstep, voffA); PG8_STAGE(PG8_SB(1, 1), cB + hstep + kstep, voffB);
    PG8_WAIT_V(6); PG8_BAR;
    PG8_STAMP();
    for (;;) {
        const bool has_next = S.next(ui + 1, nxt);
        const char* nA = has_next ? (const char*)g.A + (size_t)nxt.pm * tstep : cA; const char* nB = has_next ? (const char*)g.Bt + (size_t)nxt.pn * tstep : cB;
        for (int t = 0; t < nt; t += 2) {
            const bool last = (t == nt - 2);
            const char* a1 = cA + (size_t)(t + 1) * kstep;
            const char* a2 = last ? nA : cA + (size_t)(t + 2) * kstep; const char* b2 = last ? nB : cB + (size_t)(t + 2) * kstep;
            const char* a3 = a2 + kstep; const char* b3 = b2 + kstep;
            if (last && has_next) S.a_ready(nxt);
            PG8_LDB(B0, 0, 0); PG8_SCHED; PG8_LDA(At, 0, 0); PG8_STAGE(PG8_SA(1, 1), a1 + hstep, voffA);
            PG8_WAIT_L(8); PG8_BAR; PG8_WAIT_L(0); PG8_MMA(0, 0, At, B0); PG8_BAR; PG8_SCHED;
            PG8_LDB(B1, 0, 1); PG8_STAGE(PG8_SB(0, 0), b2, voffB);
            PG8_BAR; PG8_WAIT_L(0); PG8_MMA(0, 1, At, B1); PG8_BAR;
            PG8_LDA(At, 0, 1); PG8_STAGE(PG8_SA(0, 0), a2, voffA);
            PG8_BAR; PG8_WAIT_L(0); PG8_MMA(1, 0, At, B0); PG8_BAR; PG8_SCHED;
            PG8_STAGE(PG8_SB(0, 1), b2 + hstep, voffB);
            PG8_WAIT_V(6); PG8_BAR; PG8_MMA(1, 1, At, B1); PG8_BAR;
            PG8_LDB(B0, 1, 0); PG8_SCHED; PG8_LDA(At, 1, 0); PG8_STAGE(PG8_SA(0, 1), a2 + hstep, voffA);
            PG8_WAIT_L(8); PG8_BAR; PG8_WAIT_L(0); PG8_MMA(0, 0, At, B0); PG8_BAR; PG8_SCHED;
            PG8_LDB(B1, 1, 1); PG8_STAGE(PG8_SB(1, 0), b3, voffB);
            PG8_BAR; PG8_WAIT_L(0); PG8_MMA(0, 1, At, B1); PG8_BAR;
            PG8_LDA(At, 1, 1); PG8_STAGE(PG8_SA(1, 0), a3, voffA);
            PG8_BAR; PG8_WAIT_L(0); PG8_MMA(1, 0, At, B0); PG8_BAR; PG8_SCHED;
            PG8_STAGE(PG8_SB(1, 1), b3 + hstep, voffB);
            PG8_WAIT_V(6); PG8_BAR; PG8_MMA(1, 1, At, B1); PG8_BAR;
        }
        PG8_STAMP();
        if constexpr (!Epi::AFTER_DRAIN) { E(acc, cur, wr, wc, fr, fq); S.done(cur); }
        PG8_STAMP();
        if (!has_next) break;
#pragma unroll
        for (int a = 0; a < 2; ++a)
#pragma unroll
            for (int b = 0; b < 2; ++b)
#pragma unroll
                for (int m = 0; m < 4; ++m)
#pragma unroll
                    for (int n = 0; n < 2; ++n) acc[a][b][m][n] = (f32x4){0.f, 0.f, 0.f, 0.f};
        cur = nxt; cA = nA; cB = nB; ++ui;
    }
    PG8_WAIT_V(0);
    if (wr == 0) PG8_BAR;
    PG8_BAR;
    if constexpr (Epi::AFTER_DRAIN) { E.fused(acc, cur, wr, wc, fr, fq, lds, wid, lane); S.done(cur); }
    PG8_STAMP();
    if (STAMP && wid == 0) { stamps[lane] = lane < nts ? (((unsigned long long)(unsigned)ts_hi << 32) | (unsigned)ts_lo) : 0ull;
        if (lane == 62) stamps[62] = rt_entry; if (lane == 63) stamps[63] = (unsigned long long)wall_clock64(); }
#undef PG8_STAMP
#undef PG8_SA
#undef PG8_SB
#undef PG8_STAGE
#undef PG8_LDA
#undef PG8_LDB
#undef PG8_MMA
#undef PG8_WAIT_V
#undef PG8_WAIT_L
#undef PG8_BAR
#undef PG8_SCHED
}
}

using pg8::bf16_t; using pg8::bf16x8; using pg8::f32x4; using pg8::u32x4; using pg8::cvt_pk_bf16;

constexpr int NTOK = 12288, DM = 1024, NCTX = 4096;
constexpr size_t MB = 1048576;
constexpr size_t OFF_WIN = 0, OFF_WOUT = 8 * MB, OFF_WGU = 10 * MB, OFF_WDN = 21 * MB, OFF_H = 27 * MB, OFF_MOD = 51 * MB, OFF_SIDE = 52 * MB,
                 OFF_HID2 = 53 * MB, OFF_GL = 54 * MB + MB / 2, OFF_BIG = 55 * MB;
constexpr size_t B_QKV = OFF_BIG, B_ZG = OFF_BIG + 72 * MB, B_PREPD = OFF_BIG + 96 * MB, B_PREPR = B_PREPD + 108 * MB, B_ODIR = OFF_BIG;
constexpr size_t B_U = OFF_BIG, B_VXT = OFF_BIG + 72 * MB, B_KERN = OFF_BIG + 120 * MB, B_KERN256 = B_KERN + 32 * MB;
constexpr size_t B_GU = OFF_BIG, B_ACT = OFF_BIG + 132 * MB;
constexpr size_t WS_NEED = 343 * MB;
constexpr size_t OFF_BAR = 54 * MB + 3 * MB / 4;
constexpr int LDS_BYTES = 144 * 1024;
constexpr int ITEM_D = 73728, ITEM_R = 57344;
constexpr int PO_QD = 0, PO_KDT = 8192, PO_ATT = 16384, PO_U = 20480, PO_W = 28672;

enum { I_XP = 0, I_XS, I_SD, I_SR, I_C, I_CCTX, I_MODW, I_MODB, I_NORM1, I_NORM2, I_ABWIN, I_ABCONV, I_ALOG, I_DTB, I_NA, I_NB, I_RDEC, I_ABWOUT,
       I_HYWIN, I_HYBIN, I_HYCW, I_HYCB, I_FW1, I_FB1, I_FF1, I_FW2, I_FB2, I_FF2, I_FW3, I_FBIAS, I_HYWOUT, I_HYBOUT, I_FG, I_FU, I_FCONV, I_FCB, I_FD, I_FNORM, N_IN };

struct Params { const float* in[N_IN]; float* out; unsigned char* ws; int lo, hi; };

__device__ __forceinline__ float shx(float v, int m, int lane) { return __int_as_float(__builtin_amdgcn_ds_bpermute((lane ^ m) << 2, __float_as_int(v))); }
__device__ __forceinline__ float wsum(float v, int lane) {
#pragma unroll
    for (int o = 32; o; o >>= 1) v += shx(v, o, lane);
    return v; }
__device__ __forceinline__ bf16_t f2bf(float f) { return (bf16_t)(cvt_pk_bf16(f, 0.f) & 0xffffu); }
__device__ __forceinline__ float bf2f(bf16_t b) { return __uint_as_float(((unsigned)b) << 16); }
__device__ __forceinline__ float bflo(unsigned u) { return __uint_as_float(u << 16); }
__device__ __forceinline__ float bfhi(unsigned u) { return __uint_as_float(u & 0xffff0000u); }
__device__ __forceinline__ float silu(float x) { return x / (1.0f + __expf(-x)); }
__device__ __forceinline__ void tokinfo(int tok, int& sbase, int& L) { if (tok < NCTX) { sbase = tok & ~255; L = 256; } else { sbase = NCTX + ((tok - NCTX) & ~4095); L = 4096; } }
__device__ __forceinline__ void unpack8(const uint4 u, float* f) { f[0] = bflo(u.x); f[1] = bfhi(u.x); f[2] = bflo(u.y); f[3] = bfhi(u.y); f[4] = bflo(u.z); f[5] = bfhi(u.z); f[6] = bflo(u.w); f[7] = bfhi(u.w); }
__device__ __forceinline__ uint4 pack8(const float* f) { uint4 u; u.x = cvt_pk_bf16(f[0], f[1]); u.y = cvt_pk_bf16(f[2], f[3]); u.z = cvt_pk_bf16(f[4], f[5]); u.w = cvt_pk_bf16(f[6], f[7]); return u; }

struct EpiBf16S {
    static constexpr bool PERM = true, AFTER_DRAIN = false;
    bf16_t* O1; int ld1; int nsplit; bf16_t* O2; int ld2; const float* bias;
    __device__ __forceinline__ void operator()(const f32x4 (&acc)[2][2][4][2], const pg8::Unit& u, int wr, int wc, int fr, int fq) const {
        const int row0 = u.pm * 256 + wr * 64 + fr; bf16_t* base; int ldc, colt;
        if (u.pn < nsplit) { base = O1; ldc = ld1; colt = u.pn * 256; } else { base = O2; ldc = ld2; colt = (u.pn - nsplit) * 256; }
        const int col0 = colt + wc * 32 + 8 * fq, bcol0 = u.pn * 256 + wc * 32 + 8 * fq;
#pragma unroll
        for (int bj = 0; bj < 2; ++bj) {
            f32x4 b0 = {0.f, 0.f, 0.f, 0.f}, b1 = {0.f, 0.f, 0.f, 0.f};
            if (bias) { b0 = *(const f32x4*)(bias + bcol0 + bj * 128); b1 = *(const f32x4*)(bias + bcol0 + bj * 128 + 4); }
#pragma unroll
            for (int ai = 0; ai < 2; ++ai)
#pragma unroll
                for (int m = 0; m < 4; ++m) {
                    bf16_t* rowp = base + (size_t)(row0 + ai * 128 + m * 16) * ldc + col0 + bj * 128;
                    f32x4 v0 = acc[ai][bj][m][0] + b0, v1 = acc[ai][bj][m][1] + b1;
                    u32x4 w; w.x = cvt_pk_bf16(v0[0], v0[1]); w.y = cvt_pk_bf16(v0[2], v0[3]); w.z = cvt_pk_bf16(v1[0], v1[1]); w.w = cvt_pk_bf16(v1[2], v1[3]);
                    *(u32x4*)rowp = w; }
        }
    }
};
struct EpiRes {
    static constexpr bool PERM = false, AFTER_DRAIN = false;
    float* X; const float* gate; const float* bias;
    __device__ __forceinline__ void operator()(const f32x4 (&acc)[2][2][4][2], const pg8::Unit& u, int wr, int wc, int fr, int fq) const {
        const int row0 = u.pm * 256 + wr * 64 + fr, col0 = u.pn * 256 + wc * 32 + 4 * fq;
        const int vec = (u.pm < 16) ? 0 : 1 + ((u.pm - 16) >> 4);
        const float* g = gate + vec * 6144;
#pragma unroll
        for (int bj = 0; bj < 2; ++bj)
#pragma unroll
            for (int n = 0; n < 2; ++n) {
                const int c = col0 + bj * 128 + n * 16;
                const f32x4 gv = *(const f32x4*)(g + c);
                f32x4 bv = {0.f, 0.f, 0.f, 0.f}; if (bias) bv = *(const f32x4*)(bias + c);
                float* px = X + (size_t)row0 * DM + c;
                f32x4 xv[8];
#pragma unroll
                for (int q = 0; q < 8; ++q) xv[q] = __builtin_nontemporal_load((const f32x4*)(px + (size_t)((q >> 2) * 128 + (q & 3) * 16) * DM));
#pragma unroll
                for (int q = 0; q < 8; ++q) xv[q] += gv * (acc[q >> 2][bj][q & 3][n] + bv);
#pragma unroll
                for (int q = 0; q < 8; ++q) *(f32x4*)(px + (size_t)((q >> 2) * 128 + (q & 3) * 16) * DM) = xv[q];
            }
    }
};

template <class Epi> __device__ __forceinline__ void run_gemm(unsigned char* shm, const bf16_t* A, const bf16_t* Bt, int N, int K, const Epi& E) {
    pg8::Gemm g; g.A = A; g.Bt = Bt; g.M = NTOK; g.N = N; g.K = K;
    pg8::StaticOrder S; S.init(NTOK, N, (int)gridDim.x, lbid());
    pg8::gemm_phase<Epi, pg8::StaticOrder, false>((PG8_LAS unsigned char*)shm, g, S, E, nullptr);
}

__device__ __forceinline__ void conv_seg(const float* __restrict__ src, int ld, int K, int col0, int ncols, bf16_t* __restrict__ dst, int& base, float* tile, int vb, int G) {
    const int nkt = K >> 6, n = nkt * (ncols >> 7);
    const int start = (vb - base % G + G) % G;
    const int tid0 = ltid(); const int n4 = (tid0 & 31) * 4, kk0 = tid0 >> 5;
    float4 v[4];
#define CV_LOAD(it_) do { const int kt_ = (it_) % nkt, ct_ = (it_) / nkt; const float* s_ = src + (size_t)(kt_ * 64) * ld + col0 + ct_ * 128; \
        _Pragma("unroll") for (int i = 0; i < 4; ++i) { const f32x4 t_ = __builtin_nontemporal_load((const f32x4*)(s_ + (size_t)(kk0 + 16 * i) * ld + n4)); v[i] = make_float4(t_[0], t_[1], t_[2], t_[3]); } } while (0)
    if (start < n) CV_LOAD(start);
    for (int it = start; it < n; it += G) {
        const int kt = it % nkt, ct = it / nkt;
#pragma unroll
        for (int i = 0; i < 4; ++i) { float* tp = tile + (kk0 + 16 * i) * 129 + n4; tp[0] = v[i].x; tp[1] = v[i].y; tp[2] = v[i].z; tp[3] = v[i].w; }
        if (it + G < n) CV_LOAD(it + G);
        __syncthreads();
        const int kc = tid0 & 7, nn = tid0 >> 3;
#pragma unroll
        for (int i = 0; i < 2; ++i) { const int c = nn + 64 * i; float f[8];
#pragma unroll
            for (int e = 0; e < 8; ++e) f[e] = tile[(kc * 8 + e) * 129 + c];
            *(uint4*)(dst + (size_t)(ct * 128 + c) * K + kt * 64 + kc * 8) = pack8(f); }
        __syncthreads();
    }
#undef CV_LOAD
    base += n;
}
__device__ __forceinline__ void convert_mixer(const Params& p, int l, unsigned char* shm, int vb, int nb) {
    float* tile = (float*)shm; int base = 0; const int j = l >> 1;
    bf16_t* win = (bf16_t*)(p.ws + OFF_WIN); bf16_t* wout = (bf16_t*)(p.ws + OFF_WOUT);
    if ((l & 1) == 0) {
        const float* w = p.in[I_ABWIN] + (size_t)j * 1024 * 4112;
        conv_seg(w, 4112, 1024, 0, 1536, win, base, tile, vb, nb);
        conv_seg(w, 4112, 1024, 2064, 1536, win + (size_t)1536 * 1024, base, tile, vb, nb);
        conv_seg(w, 4112, 1024, 1536, 512, win + (size_t)3072 * 1024, base, tile, vb, nb);
        conv_seg(w, 4112, 1024, 3600, 512, win + (size_t)3584 * 1024, base, tile, vb, nb);
        conv_seg(p.in[I_ABWOUT] + (size_t)j * 1024 * 1024, 1024, 1024, 0, 1024, wout, base, tile, vb, nb);
    } else {
        conv_seg(p.in[I_HYWIN] + (size_t)j * 1024 * 3072, 3072, 1024, 0, 3072, win, base, tile, vb, nb);
        conv_seg(p.in[I_HYWOUT] + (size_t)j * 1024 * 1024, 1024, 1024, 0, 1024, wout, base, tile, vb, nb);
    }
}
__device__ __forceinline__ void convert_ffn(const Params& p, int l, unsigned char* shm, int vb, int nb) {
    float* tile = (float*)shm; int base = 0;
    bf16_t* wgu = (bf16_t*)(p.ws + OFF_WGU); bf16_t* wdn = (bf16_t*)(p.ws + OFF_WDN);
    conv_seg(p.in[I_FG] + (size_t)l * 1024 * 2816, 2816, 1024, 0, 2816, wgu, base, tile, vb, nb);
    conv_seg(p.in[I_FU] + (size_t)l * 1024 * 2816, 2816, 1024, 0, 2816, wgu + (size_t)2816 * 1024, base, tile, vb, nb);
    conv_seg(p.in[I_FD] + (size_t)l * 2816 * 1024, 1024, 2816, 0, 1024, wdn, base, tile, vb, nb);
}

__device__ __forceinline__ void phase_prologue(const Params& p, unsigned char* shm) {
    const int tid = ltid(), G = (int)gridDim.x;
    {   const float4* a = (const float4*)p.in[I_XP]; const float4* b = (const float4*)p.in[I_XS]; float4* o = (float4*)p.out;
        const size_t na = (size_t)NCTX * DM / 4, nt = (size_t)NTOK * DM / 4;
        for (size_t i = (size_t)lbid() * 512 + tid; i < nt; i += (size_t)G * 512) o[i] = i < na ? a[i] : b[i - na]; }
    float* sv = (float*)shm; float* red = sv + 3072;
    for (int i = tid; i < 3072; i += 512) { const int v = i >> 10, k = i & 1023; const float x = v == 0 ? p.in[I_CCTX][k] : p.in[I_C][(v - 1) * 1024 + k]; sv[i] = silu(x); }
    __syncthreads();
    float* MOD = (float*)(p.ws + OFF_MOD);
    for (int it = lbid(); it < 768; it += G) {
        const int l = it / 192, cb = (it % 192) * 32, cl = tid & 31, kg = tid >> 5;
        const float* w = p.in[I_MODW] + (size_t)l * 1024 * 6144 + cb + cl;
        float a0 = 0.f, a1 = 0.f, a2 = 0.f;
#pragma unroll 16
        for (int k = kg * 64; k < kg * 64 + 64; ++k) { const float wv = __builtin_nontemporal_load(w + (size_t)k * 6144); a0 += sv[k] * wv; a1 += sv[1024 + k] * wv; a2 += sv[2048 + k] * wv; }
        red[(0 * 16 + kg) * 32 + cl] = a0; red[(1 * 16 + kg) * 32 + cl] = a1; red[(2 * 16 + kg) * 32 + cl] = a2;
        __syncthreads();
        if (tid < 96) { const int v = tid >> 5, c = tid & 31; float s = 0.f;
#pragma unroll
            for (int q = 0; q < 16; ++q) s += red[(v * 16 + q) * 32 + c];
            MOD[(l * 3 + v) * 6144 + cb + c] = s + p.in[I_MODB][l * 6144 + cb + c]; }
        __syncthreads();
    }
    convert_mixer(p, 0, shm, lbid(), (int)gridDim.x);
}

__device__ __forceinline__ void norm_rows(const Params& p, int l, int which, unsigned char* shm) {
    const int tid = ltid(), lane = tid & 63, wid = tid >> 6;
    const float* nw = which == 0 ? p.in[I_NORM1] + l * 1024 : which == 1 ? p.in[I_NORM2] + l * 1024 : p.in[I_FNORM];
    const bool side = (which == 0) && ((l & 1) == 0);
    float* w16 = (float*)shm;
    if (side) {
        const float* w = p.in[I_ABWIN] + (size_t)(l >> 1) * 1024 * 4112 + 2048;
#pragma unroll 4
        for (int i0 = 0; i0 < 8; ++i0) { float4 v4[1]; const int f = tid + i0 * 512;
            const int k = f >> 2, qd = f & 3; v4[0] = *(const float4*)(w + (size_t)k * 4112 + qd * 4);
            const int slot = ((k >> 8) * 4 + (k & 3)) * 64 + ((k >> 2) & 63); *(float4*)(w16 + slot * 16 + qd * 4) = v4[0]; }
        __syncthreads();
    }
    const float* MOD = (const float*)(p.ws + OFF_MOD);
    bf16_t* H = (bf16_t*)(p.ws + OFF_H); float* SIDE = (float*)(p.ws + OFF_SIDE);
    const int rstride = (int)gridDim.x * 8;
    int row = lbid() * 8 + wid;
    float4 vn[4];
    if (row < NTOK) {
#pragma unroll
        for (int i = 0; i < 4; ++i) vn[i] = *(const float4*)(p.out + (size_t)row * DM + i * 256 + lane * 4); }
    for (; row < NTOK; row += rstride) {
        float* xr = p.out + (size_t)row * DM;
        float4 v[4]; float ss = 0.f;
        const int vec = row < NCTX ? 0 : 1 + ((row - NCTX) >> 12);
        const float* md = MOD + (l * 3 + vec) * 6144 + (which == 1 ? 3072 : 0);
        float4 g4[4], sh4[4], sc4[4];
#pragma unroll
        for (int i = 0; i < 4; ++i) { g4[i] = *(const float4*)(nw + i * 256 + lane * 4); if (which != 2) { sh4[i] = *(const float4*)(md + i * 256 + lane * 4); sc4[i] = *(const float4*)(md + 1024 + i * 256 + lane * 4); } }
#pragma unroll
        for (int i = 0; i < 4; ++i) { v[i] = vn[i]; ss += v[i].x * v[i].x + v[i].y * v[i].y + v[i].z * v[i].z + v[i].w * v[i].w; }
        if (row + rstride < NTOK) {
#pragma unroll
            for (int i = 0; i < 4; ++i) vn[i] = *(const float4*)(p.out + (size_t)(row + rstride) * DM + i * 256 + lane * 4); }
        ss = wsum(ss, lane);
        const float r = rsqrtf(ss * (1.0f / 1024.0f) + 1e-6f);
        if (which == 2) {
#pragma unroll
            for (int i = 0; i < 4; ++i) { const float4 g = g4[i];
                float4 y; y.x = v[i].x * r * g.x; y.y = v[i].y * r * g.y; y.z = v[i].z * r * g.z; y.w = v[i].w * r * g.w; *(float4*)(xr + i * 256 + lane * 4) = y; }
        } else {
            float sacc[16];
#pragma unroll
            for (int q = 0; q < 16; ++q) sacc[q] = 0.f;
#pragma unroll
            for (int i = 0; i < 4; ++i) { const int k = i * 256 + lane * 4;
                const float4 g = g4[i], sh = sh4[i], sc = sc4[i];
                float hv[4]; hv[0] = v[i].x * r * g.x * (1.f + sc.x) + sh.x; hv[1] = v[i].y * r * g.y * (1.f + sc.y) + sh.y; hv[2] = v[i].z * r * g.z * (1.f + sc.z) + sh.z; hv[3] = v[i].w * r * g.w * (1.f + sc.w) + sh.w;
                uint2 pk; pk.x = cvt_pk_bf16(hv[0], hv[1]); pk.y = cvt_pk_bf16(hv[2], hv[3]);
                *(uint2*)(H + (size_t)row * DM + k) = pk;
                if (side) {
#pragma unroll
                    for (int e = 0; e < 4; ++e) { const float4* wp = (const float4*)(w16 + ((i * 4 + e) * 64 + lane) * 16);
#pragma unroll
                        for (int q = 0; q < 4; ++q) { const float4 wv = wp[q]; sacc[q * 4 + 0] += hv[e] * wv.x; sacc[q * 4 + 1] += hv[e] * wv.y; sacc[q * 4 + 2] += hv[e] * wv.z; sacc[q * 4 + 3] += hv[e] * wv.w; } }
                }
            }
            if (side) {
                const bool b5 = lane & 32, b4 = lane & 16, b3 = lane & 8, b2 = lane & 4;
                float t8[8], t4[4], t2[2];
#pragma unroll
                for (int i = 0; i < 8; ++i) { const float snd = b5 ? sacc[i] : sacc[i + 8], kp = b5 ? sacc[i + 8] : sacc[i]; t8[i] = kp + shx(snd, 32, lane); }
#pragma unroll
                for (int i = 0; i < 4; ++i) { const float snd = b4 ? t8[i] : t8[i + 4], kp = b4 ? t8[i + 4] : t8[i]; t4[i] = kp + shx(snd, 16, lane); }
#pragma unroll
                for (int i = 0; i < 2; ++i) { const float snd = b3 ? t4[i] : t4[i + 2], kp = b3 ? t4[i + 2] : t4[i]; t2[i] = kp + shx(snd, 8, lane); }
                float t1 = (b2 ? t2[1] : t2[0]) + shx(b2 ? t2[0] : t2[1], 4, lane);
                t1 += shx(t1, 2, lane); t1 += shx(t1, 1, lane);
                if ((lane & 3) == 0) SIDE[(size_t)row * 16 + ((lane >> 5) & 1) * 8 + ((lane >> 4) & 1) * 4 + ((lane >> 3) & 1) * 2 + ((lane >> 2) & 1)] = t1;
            }
        }
    }
}

__device__ __forceinline__ void hyena_hid2(const Params& p, int l, unsigned char* shm) {
    const int tid = ltid(), j = l >> 1;
    float* zf = (float*)shm;
    float* h1 = zf + 8 * 36;
    const float* w1 = p.in[I_FW1] + j * 33 * 64; const float* b1 = p.in[I_FB1] + j * 64; const float* f1 = p.in[I_FF1] + j * 64;
    const float* w2 = p.in[I_FW2] + j * 64 * 64; const float* b2 = p.in[I_FB2] + j * 64; const float* f2 = p.in[I_FF2] + j * 64;
    float* HID2 = (float*)(p.ws + OFF_HID2);
    for (int it = lbid(); it < 544; it += (int)gridDim.x) {
        const int row0 = it * 8;
        if (tid < 8 * 33) { const int r = tid / 33, e = tid % 33; const int rg = row0 + r; const int L = rg < 4096 ? 4096 : 256; const int i = rg < 4096 ? rg : rg - 4096;
            float val;
            if (e == 0) val = (float)i / (float)(L - 1);
            else { const int kb = (e - 1) & 15; const float band = 1e-4f + (float)kb * 0.99999333f; float rr = band * (float)i / (float)L; rr -= floorf(rr);
                val = (e <= 16) ? __builtin_amdgcn_cosf(rr) : -__builtin_amdgcn_sinf(rr); }
            zf[r * 36 + e] = val; }
        __syncthreads();
        const int r = tid >> 6, k = tid & 63;
        { float a = b1[k];
#pragma unroll
          for (int e = 0; e < 33; ++e) a += zf[r * 36 + e] * w1[e * 64 + k];
          h1[r * 64 + k] = __sinf(f1[k] * a); }
        __syncthreads();
        { float a = b2[k];
#pragma unroll 16
          for (int m = 0; m < 64; ++m) a += h1[r * 64 + m] * w2[m * 64 + k];
          HID2[(size_t)(row0 + r) * 64 + k] = __sinf(f2[k] * a); }
        __syncthreads();
    }
}

#define TSW(col, r) ((col) * 72 + (((((r) >> 3) ^ (((col) >> 4) & 7)) << 3) | ((r) & 7)))
#ifndef PREP_SKIP
#define PREP_SKIP 0
#endif
__device__ __forceinline__ void phase_prep(const Params& p, int l, unsigned char* shm, int it_lo = 0, int it_hi = 3072, bool dmy = false) {
    const int j = l >> 1;
    bf16_t* qs = (bf16_t*)shm;
    bf16_t* ks = qs + 64 * 136;
    bf16_t* vT = ks + 64 * 136;
    bf16_t* kT = vT + 128 * 72;
    bf16_t* kdTs = kT + 128 * 72;
    bf16_t* Ts = kdTs + 128 * 72;
    float* Lm = (float*)(Ts + 64 * 72);
    float* gs = Lm + 64 * 68; float* gcs = gs + 64; float* bts = gcs + 64; float* Xs = bts + 64;
    const bf16_t* QKV = (const bf16_t*)(p.ws + B_QKV); const float* SIDE = (const float*)(p.ws + OFF_SIDE); float* GL = (float*)(p.ws + OFF_GL);
    const float* cw = p.in[I_ABCONV] + j * 3 * 1536;
    for (int it = it_lo + lbid(); it < it_hi; it += (int)gridDim.x) {
        const int tid = ltid(), lane = tid & 63, wid = tid >> 6, fr = lane & 15, fq = lane >> 4;
        const int ty = it / 1536, r1 = it % 1536, d = r1 / 768, r2 = r1 % 768, h = r2 / 192, cgi = r2 % 192;
        const int tok0 = cgi * 64; int sbase, L; tokinfo(tok0, sbase, L);
        bf16_t* item = ty == 0 ? (bf16_t*)(p.ws + B_PREPD + (size_t)((d * 4 + h) * 192 + cgi) * ITEM_D) : (bf16_t*)(p.ws + B_PREPR + (size_t)((d * 4 + h) * 192 + cgi) * ITEM_R);
        if (dmy) item = (bf16_t*)(p.ws + 344 * MB + (size_t)(it & 255) * ITEM_D);
        const int r_ = tid >> 3, jj = tid & 7;
        const int t = d ? tok0 + 63 - r_ : tok0 + r_;
        uint4 vp0, vp1;
        vp0 = make_uint4(0, 0, 0, 0); vp1 = vp0;
        if (ty == 0 && !(dmy && (PREP_SKIP & 2))) {
#pragma unroll
            for (int part = 0; part < 3; ++part) {
                const int col = part * 512 + h * 128 + jj * 16;
                float a[16];
#pragma unroll
                for (int e = 0; e < 16; ++e) a[e] = 0.f;
                uint4 ld0[3], ld1[3];
#pragma unroll
                for (int i = 0; i < 3; ++i) { const int tt = t + i - 1; const bool ok = tt >= sbase && tt < sbase + L; const uint4* px = (const uint4*)(QKV + (size_t)(ok ? tt : t) * 3072 + col);
                    ld0[i] = px[0]; ld1[i] = px[1]; if (!ok) { ld0[i] = make_uint4(0, 0, 0, 0); ld1[i] = ld0[i]; } }
#pragma unroll
                for (int i = 0; i < 3; ++i) { float x[16]; unpack8(ld0[i], x); unpack8(ld1[i], x + 8);
                    const float4* cwp = (const float4*)(cw + i * 1536 + col);
#pragma unroll
                    for (int e4 = 0; e4 < 4; ++e4) { const float4 wv = cwp[e4]; a[e4 * 4] += x[e4 * 4] * wv.x; a[e4 * 4 + 1] += x[e4 * 4 + 1] * wv.y; a[e4 * 4 + 2] += x[e4 * 4 + 2] * wv.z; a[e4 * 4 + 3] += x[e4 * 4 + 3] * wv.w; } }
                float ssq = 0.f;
#pragma unroll
                for (int e = 0; e < 16; ++e) { a[e] = silu(a[e]); ssq += a[e] * a[e]; }
                if (part < 2) {
                    ssq += shx(ssq, 1, lane); ssq += shx(ssq, 2, lane); ssq += shx(ssq, 4, lane);
                    const float rn = rsqrtf(ssq + 1e-6f) * (part == 0 ? 0.08838834764831845f : 1.0f);
#pragma unroll
                    for (int e = 0; e < 16; ++e) a[e] *= rn;
                    bf16_t* dq = (part == 0 ? qs : ks) + r_ * 136 + jj * 16;
                    *(uint4*)dq = pack8(a); *(uint4*)(dq + 8) = pack8(a + 8);
                } else { vp0 = pack8(a); vp1 = pack8(a + 8); }
            }
        } else {
            const bf16_t* src = QKV + (size_t)t * 3072 + 1536 + h * 128 + jj * 16;
            { float a[16]; const uint4* px = (const uint4*)src; unpack8(px[0], a); unpack8(px[1], a + 8);
#pragma unroll
              for (int e = 0; e < 16; ++e) a[e] *= 0.08838834764831845f;
              *(uint4*)(qs + r_ * 136 + jj * 16) = pack8(a); *(uint4*)(qs + r_ * 136 + jj * 16 + 8) = pack8(a + 8); }
            { const uint4* px = (const uint4*)(src + 512); *(uint4*)(ks + r_ * 136 + jj * 16) = px[0]; *(uint4*)(ks + r_ * 136 + jj * 16 + 8) = px[1]; }
            { const uint4* px = (const uint4*)(src + 1024); vp0 = px[0]; vp1 = px[1]; }
        }
        if (dmy && (PREP_SKIP & 64)) continue;
        if (jj == 0) {
            float g, beta;
            if (ty == 0) { const float a_raw = SIDE[(size_t)t * 16 + d * 4 + h], b_raw = SIDE[(size_t)t * 16 + 8 + d * 4 + h];
                const float A = expf(p.in[I_ALOG][j * 8 + d * 4 + h]); const float x = a_raw + p.in[I_DTB][j * 8 + d * 4 + h];
                const float sp = x > 20.f ? x : log1pf(expf(x)); g = -A * sp; beta = 1.0f / (1.0f + expf(-b_raw)); }
            else { g = -expf(p.in[I_RDEC][j * 8 + d * 4 + h]); beta = 1.f; }
            gs[r_] = g; bts[r_] = beta; }
        __syncthreads();
        if (tid < 64) { float a = gs[tid];
#pragma unroll
            for (int o = 1; o < 64; o <<= 1) { const float tt = __int_as_float(__builtin_amdgcn_ds_bpermute(((lane - o) & 63) << 2, __float_as_int(a))); if (tid >= o) a += tt; }
            gcs[tid] = a; }
        __syncthreads();
        if (!(dmy && (PREP_SKIP & 8))) {   const float gr = gcs[r_], glast = gcs[63], eg = __expf(gr), ek = __expf(glast - gr), b = bts[r_];
            {   float q[16]; unpack8(*(const uint4*)(qs + r_ * 136 + jj * 16), q); unpack8(*(const uint4*)(qs + r_ * 136 + jj * 16 + 8), q + 8);
#pragma unroll
                for (int e = 0; e < 16; ++e) q[e] *= eg;
                *(uint4*)(item + PO_QD + r_ * 128 + jj * 16) = pack8(q); *(uint4*)(item + PO_QD + r_ * 128 + jj * 16 + 8) = pack8(q + 8); }
            if (ty == 1) { *(uint4*)(item + PO_U + r_ * 128 + jj * 16) = vp0; *(uint4*)(item + PO_U + r_ * 128 + jj * 16 + 8) = vp1; }
            {   float k[16]; unpack8(*(const uint4*)(ks + r_ * 136 + jj * 16), k); unpack8(*(const uint4*)(ks + r_ * 136 + jj * 16 + 8), k + 8);
#pragma unroll
                for (int e = 0; e < 16; ++e) { const int col = jj * 16 + e; kdTs[TSW(col, r_)] = f2bf(k[e] * ek); if (ty == 0) kT[TSW(col, r_)] = f2bf(k[e] * b * eg); } }
            if (ty == 0) { float v[16]; unpack8(vp0, v); unpack8(vp1, v + 8);
#pragma unroll
                for (int e = 0; e < 16; ++e) vT[TSW(jj * 16 + e, r_)] = f2bf(v[e] * b); }
            if (tid == 0 && !dmy) GL[((ty * 2 + d) * 4 + h) * 192 + cgi] = __expf(glast);
        }
        __syncthreads();
        {
#pragma unroll
            for (int q2 = 0; q2 < ((dmy && (PREP_SKIP & 16)) ? 0 : 2); ++q2) {
                const int tix = wid * 2 + q2, tm = tix >> 2, tn = tix & 3;
                f32x4 aQ = {0.f, 0.f, 0.f, 0.f}, aK = {0.f, 0.f, 0.f, 0.f};
#pragma unroll
                for (int k0 = 0; k0 < 128; k0 += 32) {
                    const bf16x8 fs = *(const bf16x8*)(ks + (tn * 16 + fr) * 136 + k0 + fq * 8);
                    const bf16x8 fc = *(const bf16x8*)(qs + (tm * 16 + fr) * 136 + k0 + fq * 8);
                    aQ = __builtin_amdgcn_mfma_f32_16x16x32_bf16(fs, fc, aQ, 0, 0, 0);
                    if (ty == 0) { const bf16x8 fk = *(const bf16x8*)(ks + (tm * 16 + fr) * 136 + k0 + fq * 8); aK = __builtin_amdgcn_mfma_f32_16x16x32_bf16(fs, fk, aK, 0, 0, 0); }
                }
                const int c = tm * 16 + fr, s0 = tn * 16 + fq * 4; const float gcc = gcs[c], bc = bts[c];
                float av[4], lv[4];
#pragma unroll
                for (int jx = 0; jx < 4; ++jx) { const int sx = s0 + jx; const float dec = (sx <= c) ? __expf(gcc - gcs[sx]) : 0.f; av[jx] = aQ[jx] * dec; lv[jx] = (sx < c) ? bc * aK[jx] * dec : 0.f; }
                uint2 pk; pk.x = cvt_pk_bf16(av[0], av[1]); pk.y = cvt_pk_bf16(av[2], av[3]);
                *(uint2*)(item + PO_ATT + c * 64 + s0) = pk;
                if (ty == 0) *(float4*)(Lm + c * 68 + s0) = make_float4(lv[0], lv[1], lv[2], lv[3]);
            }
        }
        __syncthreads();
        if (ty == 0) {
            for (int I = 0; I < ((dmy && (PREP_SKIP & 1)) ? 0 : 4); ++I) {
                {   const int jc = tid & 63, rr = tid >> 6, r0 = 16 * I + rr, r1 = r0 + 8;
                    float a0 = (r0 == jc) ? 1.f : 0.f, a1 = (r1 == jc) ? 1.f : 0.f;
#pragma unroll 4
                    for (int s = 0; s < 16 * I; s += 4) {
                        const float4 l0 = *(const float4*)(Lm + r0 * 68 + s), l1 = *(const float4*)(Lm + r1 * 68 + s);
                        const float x0 = Xs[s * 65 + jc], x1 = Xs[(s + 1) * 65 + jc], x2 = Xs[(s + 2) * 65 + jc], x3 = Xs[(s + 3) * 65 + jc];
                        a0 -= l0.x * x0; a0 -= l0.y * x1; a0 -= l0.z * x2; a0 -= l0.w * x3;
                        a1 -= l1.x * x0; a1 -= l1.y * x1; a1 -= l1.z * x2; a1 -= l1.w * x3; }
                    Xs[r0 * 65 + jc] = a0; Xs[r1 * 65 + jc] = a1; }
                __syncthreads();
                if (wid == 0) {
                    float x[16];
                    const float* Lb = Lm + (16 * I) * 68 + 16 * I;
#pragma unroll
                    for (int r = 0; r < 16; ++r) {
                        float a = Xs[(16 * I + r) * 65 + lane];
#pragma unroll
                        for (int s4 = 0; s4 < (r + 3) / 4; ++s4) { const float4 lv = *(const float4*)(Lb + r * 68 + s4 * 4);
                            if (s4 * 4 + 0 < r) a -= lv.x * x[s4 * 4 + 0]; if (s4 * 4 + 1 < r) a -= lv.y * x[s4 * 4 + 1]; if (s4 * 4 + 2 < r) a -= lv.z * x[s4 * 4 + 2]; if (s4 * 4 + 3 < r) a -= lv.w * x[s4 * 4 + 3]; }
                        x[r] = a;
                    }
#pragma unroll
                    for (int r = 0; r < 16; ++r) { Xs[(16 * I + r) * 65 + lane] = x[r]; Ts[(16 * I + r) * 72 + lane] = f2bf(x[r]); }
                }
                __syncthreads();
            }
#pragma unroll
            for (int q2 = 0; q2 < ((dmy && (PREP_SKIP & 4)) ? 0 : 4); ++q2) {
                const int tix = wid * 4 + q2, tm = tix >> 3, tn = tix & 7;
                f32x4 aU = {0.f, 0.f, 0.f, 0.f}, aW = {0.f, 0.f, 0.f, 0.f};
#pragma unroll
                for (int k0 = 0; k0 < 64; k0 += 32) {
                    const bf16x8 fc = *(const bf16x8*)(Ts + (tm * 16 + fr) * 72 + k0 + fq * 8);
                    const bf16x8 fu = *(const bf16x8*)(vT + TSW(tn * 16 + fr, k0 + fq * 8));
                    const bf16x8 fw = *(const bf16x8*)(kT + TSW(tn * 16 + fr, k0 + fq * 8));
                    aU = __builtin_amdgcn_mfma_f32_16x16x32_bf16(fu, fc, aU, 0, 0, 0);
                    aW = __builtin_amdgcn_mfma_f32_16x16x32_bf16(fw, fc, aW, 0, 0, 0);
                }
                const int c = tm * 16 + fr, col0 = tn * 16 + fq * 4;
                uint2 pu; pu.x = cvt_pk_bf16(aU[0], aU[1]); pu.y = cvt_pk_bf16(aU[2], aU[3]);
                uint2 pw; pw.x = cvt_pk_bf16(aW[0], aW[1]); pw.y = cvt_pk_bf16(aW[2], aW[3]);
                *(uint2*)(item + PO_U + c * 128 + col0) = pu; *(uint2*)(item + PO_W + c * 128 + col0) = pw;
            }
        }
#pragma unroll
        for (int i = 0; i < ((dmy && (PREP_SKIP & 32)) ? 0 : 2); ++i) { const int idx = tid + i * 512, row = idx >> 3, seg = idx & 7; *(uint4*)(item + PO_KDT + row * 64 + seg * 8) = *(const uint4*)(kdTs + TSW(row, seg * 8)); }
        __syncthreads();
    }
}

#ifndef SCAN_SKIP
#define SCAN_SKIP 0
#endif
__device__ __forceinline__ void scan_item(const Params& p, int l, int item, unsigned char* shm, bool dmy = false) {
    const int tid = ltid(), lane = tid & 63, wid = tid >> 6, fr = lane & 15, fq = lane >> 4, j = l >> 1;
    bf16_t* Ws = (bf16_t*)shm;
    bf16_t* Qs = Ws + 64 * 136;
    bf16_t* As = Qs + 64 * 136;
    bf16_t* Ks = As + 2 * 64 * 72;
    bf16_t* Us = Ks + 2 * 128 * 72;
    bf16_t* STs = Us + 64 * 40;
    bf16_t* VNs = STs + 32 * 136;
    float* GLs = (float*)(VNs + 32 * 72);
    int ty, seq, d, h, sl, chunk0, N, lat;
    if (item < 128) { lat = 1; ty = item >> 6; const int r = item & 63; seq = r >> 5; d = (r >> 4) & 1; h = (r >> 2) & 3; sl = r & 3; chunk0 = 64 + seq * 64; N = 64; }
    else { lat = 0; const int r0 = item - 128; ty = r0 >> 9; const int r = r0 & 511; seq = r >> 5; d = (r >> 4) & 1; h = (r >> 2) & 3; sl = r & 3; chunk0 = seq * 4; N = 4; }
    const int v0 = sl * 32;
    const unsigned char* pbase = ty == 0 ? p.ws + B_PREPD + (size_t)((d * 4 + h) * 192) * ITEM_D : p.ws + B_PREPR + (size_t)((d * 4 + h) * 192) * ITEM_R;
    const size_t istride = ty == 0 ? ITEM_D : ITEM_R;
    const float* GL = (const float*)(p.ws + OFF_GL) + ((ty * 2 + d) * 4 + h) * 192;
    bf16_t* ODIR = (bf16_t*)(p.ws + (dmy ? 336 * MB : B_ODIR));
    f32x4 ST0, ST1;
    if (lat) { const float* s0 = p.in[ty == 0 ? I_SD : I_SR] + (size_t)((((seq * 2 + j) * 2 + d) * 4 + h)) * 16384;
        ST0 = *(const f32x4*)(s0 + (wid * 16 + fr) * 128 + v0 + fq * 4); ST1 = *(const f32x4*)(s0 + (wid * 16 + fr) * 128 + v0 + 16 + fq * 4); }
    else { ST0 = (f32x4){0.f, 0.f, 0.f, 0.f}; ST1 = ST0; }
    struct Pre { uint4 w0, w1, q0, q1, k0, k1, a, u; };
    Pre PA, PB, PC, PD;
    PA.w0 = PA.w1 = PA.u = make_uint4(0, 0, 0, 0); PB = PA; PC = PA; PD = PA;
#define SCAN_LOAD(P, cgx) do { const bf16_t* it_ = (const bf16_t*)(pbase + (size_t)(cgx) * istride); const int i0_ = tid, i1_ = tid + 512; \
        if (ty == 0) { P.w0 = *(const uint4*)(it_ + PO_W + (i0_ >> 4) * 128 + (i0_ & 15) * 8); P.w1 = *(const uint4*)(it_ + PO_W + (i1_ >> 4) * 128 + (i1_ & 15) * 8); } \
        P.q0 = *(const uint4*)(it_ + PO_QD + (i0_ >> 4) * 128 + (i0_ & 15) * 8); P.q1 = *(const uint4*)(it_ + PO_QD + (i1_ >> 4) * 128 + (i1_ & 15) * 8); \
        P.k0 = *(const uint4*)(it_ + PO_KDT + i0_ * 8); P.k1 = *(const uint4*)(it_ + PO_KDT + i1_ * 8); \
        P.a = *(const uint4*)(it_ + PO_ATT + tid * 8); \
        if (tid < 256) P.u = *(const uint4*)(it_ + PO_U + (tid >> 2) * 128 + v0 + (tid & 3) * 8); } while (0)
#define SCAN_STORE(P, par_) do { const int i0_ = tid, i1_ = tid + 512; bf16_t* As_ = As + (par_) * (64 * 72); bf16_t* Ks_ = Ks + (par_) * (128 * 72); \
        if (ty == 0) { *(uint4*)(Ws + (i0_ >> 4) * 136 + (i0_ & 15) * 8) = P.w0; *(uint4*)(Ws + (i1_ >> 4) * 136 + (i1_ & 15) * 8) = P.w1; } \
        *(uint4*)(Qs + (i0_ >> 4) * 136 + (i0_ & 15) * 8) = P.q0; *(uint4*)(Qs + (i1_ >> 4) * 136 + (i1_ & 15) * 8) = P.q1; \
        *(uint4*)(Ks_ + (i0_ >> 3) * 72 + (i0_ & 7) * 8) = P.k0; *(uint4*)(Ks_ + (i1_ >> 3) * 72 + (i1_ & 7) * 8) = P.k1; \
        *(uint4*)(As_ + (tid >> 3) * 72 + (tid & 7) * 8) = P.a; \
        if (tid < 256) *(uint4*)(Us + (tid >> 2) * 40 + (tid & 3) * 8) = P.u; } while (0)
#define SCAN_ST_STORE() do { \
        STs[(fq * 4 + 0) * 136 + wid * 16 + fr] = f2bf(ST0[0]); STs[(fq * 4 + 1) * 136 + wid * 16 + fr] = f2bf(ST0[1]); STs[(fq * 4 + 2) * 136 + wid * 16 + fr] = f2bf(ST0[2]); STs[(fq * 4 + 3) * 136 + wid * 16 + fr] = f2bf(ST0[3]); \
        STs[(16 + fq * 4 + 0) * 136 + wid * 16 + fr] = f2bf(ST1[0]); STs[(16 + fq * 4 + 1) * 136 + wid * 16 + fr] = f2bf(ST1[1]); STs[(16 + fq * 4 + 2) * 136 + wid * 16 + fr] = f2bf(ST1[2]); STs[(16 + fq * 4 + 3) * 136 + wid * 16 + fr] = f2bf(ST1[3]); } while (0)
#define CHUNK_OF(n_) (chunk0 + (d ? N - 1 - (n_) : (n_)))
    const int tc = wid >> 1, tv = wid & 1;
#define SCAN_STEP(n, PNEXT, PLOAD) do { \
        const int cgi = CHUNK_OF(n); \
        if ((n) + 4 < N && !(dmy && (SCAN_SKIP & 1))) SCAN_LOAD(PLOAD, CHUNK_OF((n) + 4)); \
        const float gl = GLs[n]; \
        f32x4 aV = {0.f, 0.f, 0.f, 0.f}, aO = {0.f, 0.f, 0.f, 0.f}; \
        _Pragma("unroll") for (int k0 = 0; k0 < ((dmy && (SCAN_SKIP & 4)) ? 0 : 128); k0 += 32) { \
            const bf16x8 fb = *(const bf16x8*)(STs + (tv * 16 + fr) * 136 + k0 + fq * 8); \
            const bf16x8 fqd = *(const bf16x8*)(Qs + (tc * 16 + fr) * 136 + k0 + fq * 8); \
            aO = __builtin_amdgcn_mfma_f32_16x16x32_bf16(fb, fqd, aO, 0, 0, 0); \
            if (ty == 0) { const bf16x8 fw = *(const bf16x8*)(Ws + (tc * 16 + fr) * 136 + k0 + fq * 8); aV = __builtin_amdgcn_mfma_f32_16x16x32_bf16(fw, fb, aV, 0, 0, 0); } } \
        {   float vn0 = bf2f(Us[(tc * 16 + fq * 4 + 0) * 40 + tv * 16 + fr]) - aV[0], vn1 = bf2f(Us[(tc * 16 + fq * 4 + 1) * 40 + tv * 16 + fr]) - aV[1]; \
            float vn2 = bf2f(Us[(tc * 16 + fq * 4 + 2) * 40 + tv * 16 + fr]) - aV[2], vn3 = bf2f(Us[(tc * 16 + fq * 4 + 3) * 40 + tv * 16 + fr]) - aV[3]; \
            uint2 pk2; pk2.x = cvt_pk_bf16(vn0, vn1); pk2.y = cvt_pk_bf16(vn2, vn3); \
            *(uint2*)(VNs + (tv * 16 + fr) * 72 + tc * 16 + fq * 4) = pk2; } \
        __syncthreads(); \
        _Pragma("unroll") for (int k0 = 0; k0 < 64; k0 += 32) { \
            const bf16x8 fa = *(const bf16x8*)(As + ((n) & 1) * (64 * 72) + (tc * 16 + fr) * 72 + k0 + fq * 8); \
            const bf16x8 fb = *(const bf16x8*)(VNs + (tv * 16 + fr) * 72 + k0 + fq * 8); \
            aO = __builtin_amdgcn_mfma_f32_16x16x32_bf16(fb, fa, aO, 0, 0, 0); } \
        if (!(dmy && (SCAN_SKIP & 8))) {   const int c = tc * 16 + fr; const int tok = d ? cgi * 64 + 63 - c : cgi * 64 + c; uint2 po; po.x = cvt_pk_bf16(aO[0], aO[1]); po.y = cvt_pk_bf16(aO[2], aO[3]); \
            *(uint2*)(ODIR + ((size_t)d * NTOK + tok) * DM + ty * 512 + h * 128 + v0 + tv * 16 + fq * 4) = po; } \
        if (!(dmy && (SCAN_SKIP & 16))) {   f32x4 a = ST0 * gl, b = ST1 * gl; \
            _Pragma("unroll") for (int k0 = 0; k0 < 64; k0 += 32) { \
                const bf16x8 fb = *(const bf16x8*)(Ks + ((n) & 1) * (128 * 72) + (wid * 16 + fr) * 72 + k0 + fq * 8); \
                const bf16x8 fa0 = *(const bf16x8*)(VNs + (fr) * 72 + k0 + fq * 8); \
                const bf16x8 fa1 = *(const bf16x8*)(VNs + (16 + fr) * 72 + k0 + fq * 8); \
                a = __builtin_amdgcn_mfma_f32_16x16x32_bf16(fa0, fb, a, 0, 0, 0); \
                b = __builtin_amdgcn_mfma_f32_16x16x32_bf16(fa1, fb, b, 0, 0, 0); } \
            ST0 = a; ST1 = b; } \
        SCAN_ST_STORE(); \
        if ((n) + 1 < N && !(dmy && (SCAN_SKIP & 2))) SCAN_STORE(PNEXT, ((n) + 1) & 1); \
        __syncthreads(); } while (0)
    if (tid < N) GLs[tid] = GL[CHUNK_OF(tid)];
    SCAN_LOAD(PA, CHUNK_OF(0));
    SCAN_STORE(PA, 0); SCAN_ST_STORE();
    SCAN_LOAD(PB, CHUNK_OF(1)); SCAN_LOAD(PC, CHUNK_OF(2)); SCAN_LOAD(PD, CHUNK_OF(3));
    __syncthreads();
    for (int n = 0; n < N; n += 4) { SCAN_STEP(n, PB, PA); SCAN_STEP(n + 1, PC, PB); SCAN_STEP(n + 2, PD, PC); SCAN_STEP(n + 3, PA, PD); }
    if (!lat && !dmy) { float* o = p.out + (size_t)NTOK * DM + (ty ? 4194304 : 0) + (size_t)((((seq * 2 + j) * 2 + d) * 4 + h)) * 16384;
        *(f32x4*)(o + (wid * 16 + fr) * 128 + v0 + fq * 4) = ST0; *(f32x4*)(o + (wid * 16 + fr) * 128 + v0 + 16 + fq * 4) = ST1; }
#undef SCAN_LOAD
#undef SCAN_STORE
#undef SCAN_ST_STORE
#undef SCAN_STEP
#undef CHUNK_OF
}
__device__ __forceinline__ void phase_scan(const Params& p, int l, unsigned char* shm, bool dmy = false) {
    const int G = (int)gridDim.x, b = lbid();
    if (G == 256) {
        const int x = b & 7, i = b >> 3;
        if (i < 16) scan_item(p, l, (x * 4 + (i >> 2)) * 4 + (i & 3), shm, dmy);
        else { const int i2 = i - 16; for (int r = 0; r < 8; ++r) scan_item(p, l, 128 + (x * 32 + (i2 >> 2) + 4 * r) * 4 + (i2 & 3), shm, dmy); }
    } else for (int it = b; it < 1152; it += G) scan_item(p, l, it, shm);
}

__device__ __forceinline__ void phase_post(const Params& p, int l, unsigned char* shm) {
    const int tid = ltid(), lane = tid & 63, wid = tid >> 6, j = l >> 1;
    const bf16_t* O0 = (const bf16_t*)(p.ws + B_ODIR); const bf16_t* O1 = O0 + (size_t)NTOK * DM; const bf16_t* ZG = (const bf16_t*)(p.ws + B_ZG);
    bf16_t* H = (bf16_t*)(p.ws + OFF_H);
    const int g = lane >> 3, e0 = (lane & 7) * 16;
    const float* nrm = (g < 4 ? p.in[I_NA] : p.in[I_NB]) + j * 128 + e0;
    const int rstride = (int)gridDim.x * 8;
    int row = lbid() * 8 + wid;
    uint4 na0, na1, nb0, nb1, nz0, nz1;
#define PO_LOAD(row_) do { const size_t off_ = (size_t)(row_) * DM + g * 128 + e0; const uint4* pa = (const uint4*)(O0 + off_); na0 = pa[0]; na1 = pa[1]; \
        const uint4* pb = (const uint4*)(O1 + off_); nb0 = pb[0]; nb1 = pb[1]; const uint4* pz = (const uint4*)(ZG + off_); nz0 = pz[0]; nz1 = pz[1]; } while (0)
    if (row < NTOK) PO_LOAD(row);
    for (; row < NTOK; row += rstride) {
        const size_t off = (size_t)row * DM + g * 128 + e0;
        float a[16], b[16], z[16];
        unpack8(na0, a); unpack8(na1, a + 8); unpack8(nb0, b); unpack8(nb1, b + 8); unpack8(nz0, z); unpack8(nz1, z + 8);
        if (row + rstride < NTOK) PO_LOAD(row + rstride);
        float s = 0.f;
#pragma unroll
        for (int e = 0; e < 16; ++e) { a[e] += b[e]; s += a[e]; }
        float mu = 0.f;
        if (g >= 4) { s += shx(s, 1, lane); s += shx(s, 2, lane); s += shx(s, 4, lane); mu = s * (1.0f / 128.0f); }
        float q = 0.f;
#pragma unroll
        for (int e = 0; e < 16; ++e) { a[e] -= mu; q += a[e] * a[e]; }
        q += shx(q, 1, lane); q += shx(q, 2, lane); q += shx(q, 4, lane);
        const float r = rsqrtf(q * (1.0f / 128.0f) + 1e-6f);
#pragma unroll
        for (int e = 0; e < 16; ++e) a[e] = a[e] * r * nrm[e] * silu(z[e]);
        *(uint4*)(H + off) = pack8(a); *(uint4*)(H + off + 8) = pack8(a + 8);
    }
#undef PO_LOAD
}

__device__ __forceinline__ void hyena_kern(const Params& p, int l, unsigned char* shm, int vb, int G) {
    const int j = l >> 1;
    const float* HID2 = (const float*)(p.ws + OFF_HID2);
    const float* w3 = p.in[I_FW3] + (size_t)j * 64 * 2048; const float* fbias = p.in[I_FBIAS] + j * 1024;
    float* hs = (float*)shm;
    float* w3s = hs + 128 * 65;
    for (int it = vb; it < 544; it += G) {
        const int tid = ltid();
        const int big = it < 512; const int L = big ? 4096 : 256; const int r = big ? it : it - 512; const int pt = r >> 4, ct = r & 15;
        const int i0 = pt * 128, c0 = ct * 64; const float* hsrc = HID2 + (size_t)((big ? 0 : 4096) + i0) * 64;
        float* kern = (float*)(p.ws + (big ? B_KERN : B_KERN256));
#pragma unroll
        for (int i = 0; i < 16; ++i) { const int idx = tid + i * 512; hs[(idx >> 6) * 65 + (idx & 63)] = hsrc[idx]; }
#pragma unroll
        for (int i = 0; i < 16; ++i) { const int idx = tid + i * 512; const int k = idx >> 7, cc = idx & 127; w3s[idx] = w3[(size_t)k * 2048 + (cc < 64 ? c0 + cc : 1024 + c0 + cc - 64)]; }
        __syncthreads();
        const int pp = tid & 63, cgp = tid >> 6;
        float af[2][8], ab[2][8];
#pragma unroll
        for (int q = 0; q < 2; ++q)
#pragma unroll
            for (int e = 0; e < 8; ++e) { af[q][e] = 0.f; ab[q][e] = 0.f; }
#pragma unroll 4
        for (int k = 0; k < 64; ++k) { const float h0 = hs[pp * 65 + k], h1 = hs[(pp + 64) * 65 + k];
            const float4 f0 = *(const float4*)(w3s + k * 128 + cgp * 8), f1 = *(const float4*)(w3s + k * 128 + cgp * 8 + 4), g0 = *(const float4*)(w3s + k * 128 + 64 + cgp * 8), g1 = *(const float4*)(w3s + k * 128 + 64 + cgp * 8 + 4);
            const float wf[8] = {f0.x, f0.y, f0.z, f0.w, f1.x, f1.y, f1.z, f1.w}, wb[8] = {g0.x, g0.y, g0.z, g0.w, g1.x, g1.y, g1.z, g1.w};
#pragma unroll
            for (int e = 0; e < 8; ++e) { af[0][e] += h0 * wf[e]; ab[0][e] += h0 * wb[e]; af[1][e] += h1 * wf[e]; ab[1][e] += h1 * wb[e]; } }
#pragma unroll
        for (int q = 0; q < 2; ++q) {
            const int i = i0 + pp + q * 64; const float tt = (float)i / (float)(L - 1);
#pragma unroll
            for (int e = 0; e < 8; ++e) { const int c = c0 + cgp * 8 + e;
                const float dl = fabsf(-3.0701134573253943f + (float)c * ((-15.350567286626972f + 3.0701134573253943f) / 1023.0f));
                const float win = __expf(-tt * dl);
                float* kc = kern + (size_t)c * (2 * L);
                kc[i] = af[q][e] * win + (i == 0 ? fbias[c] : 0.f);
                if (i == 0) kc[L] = 0.f; else kc[2 * L - i] = ab[q][e] * win; }
        }
        __syncthreads();
    }
}
__device__ __forceinline__ void phase_hyena_pre(const Params& p, int l, unsigned char* shm) {
    const int tid = ltid(), j = l >> 1, G = (int)gridDim.x;
    {   float* tile = (float*)shm;
        const bf16_t* U = (const bf16_t*)(p.ws + B_U); float* VXT = (float*)(p.ws + B_VXT);
        const float* cw = p.in[I_HYCW] + (size_t)j * 3 * 3072; const float* cb = p.in[I_HYCB] + j * 3072;
        const int ch = tid & 63, tg = tid >> 6;
        bf16_t xr[2][10];
#define HP_LOAD(it_) do { const int it2 = (it_); const int tt0_ = (it2 >> 4) * 64, c_ = (it2 & 15) * 64 + ch; int sb_, L_; tokinfo(tt0_, sb_, L_); \
            _Pragma("unroll") for (int part = 1; part < 3; ++part) _Pragma("unroll") for (int e = 0; e < 10; ++e) { const int t = tt0_ + tg * 8 + e - 1; const bool ok = t >= sb_ && t < sb_ + L_; \
                const bf16_t xv = U[(size_t)(ok ? t : tt0_) * 3072 + part * 1024 + c_]; xr[part - 1][e] = ok ? xv : (bf16_t)0; } } while (0)
        if (lbid() < 3072) HP_LOAD(lbid());
        for (int it = lbid(); it < 3072; it += G) {
            const int tt0 = (it >> 4) * 64, c0 = (it & 15) * 64; int sbase, L; tokinfo(tt0, sbase, L);
            const int c = c0 + ch;
            float res[8];
#pragma unroll
            for (int e = 0; e < 8; ++e) res[e] = 1.f;
            float xc[2][10];
#pragma unroll
            for (int q = 0; q < 2; ++q)
#pragma unroll
                for (int e = 0; e < 10; ++e) xc[q][e] = bf2f(xr[q][e]);
            if (it + G < 3072) HP_LOAD(it + G);
#pragma unroll
            for (int part = 1; part < 3; ++part) { const int col = part * 1024 + c;
                const float w0 = cw[col], w1 = cw[3072 + col], w2 = cw[6144 + col], bb = cb[col];
#pragma unroll
                for (int e = 0; e < 8; ++e) res[e] *= (xc[part - 1][e] * w0 + xc[part - 1][e + 1] * w1 + xc[part - 1][e + 2] * w2 + bb); }
#pragma unroll
            for (int e = 0; e < 8; ++e) tile[ch * 65 + tg * 8 + e] = res[e];
            __syncthreads();
            {   const int r = tid >> 3, e0 = (tid & 7) * 8;
                float* dst = VXT + (size_t)sbase * DM + (size_t)(c0 + r) * L + (tt0 - sbase) + e0;
                float4 o0, o1; o0.x = tile[r * 65 + e0]; o0.y = tile[r * 65 + e0 + 1]; o0.z = tile[r * 65 + e0 + 2]; o0.w = tile[r * 65 + e0 + 3];
                o1.x = tile[r * 65 + e0 + 4]; o1.y = tile[r * 65 + e0 + 5]; o1.z = tile[r * 65 + e0 + 6]; o1.w = tile[r * 65 + e0 + 7];
                *(float4*)dst = o0; *(float4*)(dst + 4) = o1; }
            __syncthreads();
        }
#undef HP_LOAD
    }
}

#define PI(i) ((i) + ((i) >> 4))
template <bool INV> __device__ __forceinline__ float2 cmulw(float2 v, float c, float s) {
    return INV ? make_float2(v.x * c - v.y * s, v.x * s + v.y * c) : make_float2(v.x * c + v.y * s, v.y * c - v.x * s);
}
template <bool INV> __device__ __forceinline__ void bfly8(float2 (&x)[8], float fr) {
    const float hh = 0.70710678118654752f;
    const float c1 = __builtin_amdgcn_cosf(fr), s1 = __builtin_amdgcn_sinf(fr);
    const float c2 = c1 * c1 - s1 * s1, s2 = 2.f * c1 * s1, c4 = c2 * c2 - s2 * s2, s4 = 2.f * c2 * s2;
    const float tc[4] = {c1, (c1 - s1) * hh, -s1, -(c1 + s1) * hh}, ts[4] = {s1, (c1 + s1) * hh, c1, (c1 - s1) * hh};
    const float mc[2] = {c2, -s2}, ms[2] = {s2, c2};
    if (!INV) {
#pragma unroll
        for (int k = 0; k < 4; ++k) { const float2 a = x[k], b = x[k + 4]; x[k] = make_float2(a.x + b.x, a.y + b.y); x[k + 4] = cmulw<false>(make_float2(a.x - b.x, a.y - b.y), tc[k], ts[k]); }
#pragma unroll
        for (int q = 0; q < 4; ++q) { const int k = (q & 1) + (q >> 1) * 4; const float2 a = x[k], b = x[k + 2]; x[k] = make_float2(a.x + b.x, a.y + b.y); x[k + 2] = cmulw<false>(make_float2(a.x - b.x, a.y - b.y), mc[k & 1], ms[k & 1]); }
#pragma unroll
        for (int k = 0; k < 8; k += 2) { const float2 a = x[k], b = x[k + 1]; x[k] = make_float2(a.x + b.x, a.y + b.y); x[k + 1] = cmulw<false>(make_float2(a.x - b.x, a.y - b.y), c4, s4); }
    } else {
#pragma unroll
        for (int k = 0; k < 8; k += 2) { const float2 a = x[k], t = cmulw<true>(x[k + 1], c4, s4); x[k] = make_float2(a.x + t.x, a.y + t.y); x[k + 1] = make_float2(a.x - t.x, a.y - t.y); }
#pragma unroll
        for (int q = 0; q < 4; ++q) { const int k = (q & 1) + (q >> 1) * 4; const float2 a = x[k], t = cmulw<true>(x[k + 2], mc[k & 1], ms[k & 1]); x[k] = make_float2(a.x + t.x, a.y + t.y); x[k + 2] = make_float2(a.x - t.x, a.y - t.y); }
#pragma unroll
        for (int k = 0; k < 4; ++k) { const float2 a = x[k], t = cmulw<true>(x[k + 4], tc[k], ts[k]); x[k] = make_float2(a.x + t.x, a.y + t.y); x[k + 4] = make_float2(a.x - t.x, a.y - t.y); }
    }
}
template <bool INV> __device__ __forceinline__ void fft_pass8(float2* X, int s_top, int ngroups) {
    const int sh = s_top - 2, m3 = 1 << sh; const float i8 = 1.0f / (float)(8 * m3);
    const float hh = 0.70710678118654752f;
    for (int g = ltid(); g < ngroups; g += 512) {
        const int lo = g & (m3 - 1), hi = g >> sh, base = (hi << (s_top + 1)) | lo;
        float2 x[8];
#pragma unroll
        for (int k = 0; k < 8; ++k) x[k] = X[PI(base + k * m3)];
        const float fr = (float)lo * i8; const float c1 = __builtin_amdgcn_cosf(fr), s1 = __builtin_amdgcn_sinf(fr);
        const float c2 = c1 * c1 - s1 * s1, s2 = 2.f * c1 * s1, c4 = c2 * c2 - s2 * s2, s4 = 2.f * c2 * s2;
        const float tc[4] = {c1, (c1 - s1) * hh, -s1, -(c1 + s1) * hh}, ts[4] = {s1, (c1 + s1) * hh, c1, (c1 - s1) * hh};
        const float mc[2] = {c2, -s2}, ms[2] = {s2, c2};
        if (!INV) {
#pragma unroll
            for (int k = 0; k < 4; ++k) { const float2 a = x[k], b = x[k + 4]; x[k] = make_float2(a.x + b.x, a.y + b.y); x[k + 4] = cmulw<false>(make_float2(a.x - b.x, a.y - b.y), tc[k], ts[k]); }
#pragma unroll
            for (int q = 0; q < 4; ++q) { const int k = (q & 1) + (q >> 1) * 4; const float2 a = x[k], b = x[k + 2]; x[k] = make_float2(a.x + b.x, a.y + b.y); x[k + 2] = cmulw<false>(make_float2(a.x - b.x, a.y - b.y), mc[k & 1], ms[k & 1]); }
#pragma unroll
            for (int k = 0; k < 8; k += 2) { const float2 a = x[k], b = x[k + 1]; x[k] = make_float2(a.x + b.x, a.y + b.y); x[k + 1] = cmulw<false>(make_float2(a.x - b.x, a.y - b.y), c4, s4); }
        } else {
#pragma unroll
            for (int k = 0; k < 8; k += 2) { const float2 a = x[k], t = cmulw<true>(x[k + 1], c4, s4); x[k] = make_float2(a.x + t.x, a.y + t.y); x[k + 1] = make_float2(a.x - t.x, a.y - t.y); }
#pragma unroll
            for (int q = 0; q < 4; ++q) { const int k = (q & 1) + (q >> 1) * 4; const float2 a = x[k], t = cmulw<true>(x[k + 2], mc[k & 1], ms[k & 1]); x[k] = make_float2(a.x + t.x, a.y + t.y); x[k + 2] = make_float2(a.x - t.x, a.y - t.y); }
#pragma unroll
            for (int k = 0; k < 4; ++k) { const float2 a = x[k], t = cmulw<true>(x[k + 4], tc[k], ts[k]); x[k] = make_float2(a.x + t.x, a.y + t.y); x[k + 4] = make_float2(a.x - t.x, a.y - t.y); }
        }
#pragma unroll
        for (int k = 0; k < 8; ++k) X[PI(base + k * m3)] = x[k];
    }
    __syncthreads();
}
__device__ __forceinline__ void fft_pass2(float2* X, int npairs) {
    for (int g = ltid(); g < npairs; g += 512) { const int q = PI(2 * g); const float2 a = X[q], b = X[q + 1]; X[q] = make_float2(a.x + b.x, a.y + b.y); X[q + 1] = make_float2(a.x - b.x, a.y - b.y); }
    __syncthreads();
}
__device__ __forceinline__ void fft_fwd(float2* X, int lgN, int nelem, bool do_p2 = true) {
    int s = lgN - 1;
    for (; s >= 2; s -= 3) fft_pass8<false>(X, s, nelem >> 3);
    if (s == 0 && do_p2) fft_pass2(X, nelem >> 1);
}
__device__ __forceinline__ void fft_inv(float2* X, int lgN, int goff, int nelem, bool do_p2 = true, int s_last = 1000) {
    int s;
    if ((lgN - 1) % 3 == 0 && !do_p2) s = 3;
    else if ((lgN - 1) % 3 == 0) { for (int g = ltid(); g < (nelem >> 1); g += 512) { const int q = PI(8 * goff + 2 * g); const float2 a = X[q], b = X[q + 1]; X[q] = make_float2(a.x + b.x, a.y + b.y); X[q + 1] = make_float2(a.x - b.x, a.y - b.y); } __syncthreads(); s = 3; } else s = 2;
    for (; s <= lgN - 1 && s <= s_last; s += 3) {
        const int sh = s - 2, m3 = 1 << sh; const float i8 = 1.0f / (float)(8 * m3); const float hh = 0.70710678118654752f;
        for (int g0 = ltid(); g0 < (nelem >> 3); g0 += 512) {
            const int g = g0 + goff; const int lo = g & (m3 - 1), hi = g >> sh, base = (hi << (s + 1)) | lo;
            float2 x[8];
#pragma unroll
            for (int k = 0; k < 8; ++k) x[k] = X[PI(base + k * m3)];
            const float fr = (float)lo * i8; const float c1 = __builtin_amdgcn_cosf(fr), s1 = __builtin_amdgcn_sinf(fr);
            const float c2 = c1 * c1 - s1 * s1, s2 = 2.f * c1 * s1, c4 = c2 * c2 - s2 * s2, s4 = 2.f * c2 * s2;
            const float tc[4] = {c1, (c1 - s1) * hh, -s1, -(c1 + s1) * hh}, ts[4] = {s1, (c1 + s1) * hh, c1, (c1 - s1) * hh};
            const float mc[2] = {c2, -s2}, ms[2] = {s2, c2};
#pragma unroll
            for (int k = 0; k < 8; k += 2) { const float2 a = x[k], t = cmulw<true>(x[k + 1], c4, s4); x[k] = make_float2(a.x + t.x, a.y + t.y); x[k + 1] = make_float2(a.x - t.x, a.y - t.y); }
#pragma unroll
            for (int q = 0; q < 4; ++q) { const int k = (q & 1) + (q >> 1) * 4; const float2 a = x[k], t = cmulw<true>(x[k + 2], mc[k & 1], ms[k & 1]); x[k] = make_float2(a.x + t.x, a.y + t.y); x[k + 2] = make_float2(a.x - t.x, a.y - t.y); }
#pragma unroll
            for (int k = 0; k < 4; ++k) { const float2 a = x[k], t = cmulw<true>(x[k + 4], tc[k], ts[k]); x[k] = make_float2(a.x + t.x, a.y + t.y); x[k + 4] = make_float2(a.x - t.x, a.y - t.y); }
#pragma unroll
            for (int k = 0; k < 8; ++k) X[PI(base + k * m3)] = x[k];
        }
        __syncthreads();
    }
}
__device__ __forceinline__ void phase_hyena_fft(const Params& p, int l, unsigned char* shm) {
    const int G = (int)gridDim.x;
    float2* X = (float2*)shm;
    float* VXT = (float*)(p.ws + B_VXT);
    for (int it = lbid(); it < 2048; it += G) {
        const int tid = ltid();
        if (it < 1024) {
            const int c = it; const float* kern = (const float*)(p.ws + B_KERN) + (size_t)c * 8192;
            float* y0 = VXT + (size_t)NCTX * DM + (size_t)c * 4096; float* y1 = y0 + (size_t)4096 * DM;
#pragma unroll
            for (int q = 0; q < 4; ++q) {
                const int g = tid + q * 512, lo = g & 1023, hi = g >> 10;
                float2 x[8];
                if (hi == 0) {
#pragma unroll
                    for (int k = 0; k < 8; ++k) x[k] = make_float2(kern[lo + 1024 * k], 0.f);
                } else {
#pragma unroll
                    for (int k = 0; k < 4; ++k) x[k] = make_float2(y0[lo + 1024 * k], y1[lo + 1024 * k]);
#pragma unroll
                    for (int k = 4; k < 8; ++k) x[k] = make_float2(0.f, 0.f);
                }
                bfly8<false>(x, (float)lo * (1.0f / 8192.0f));
#pragma unroll
                for (int k = 0; k < 8; ++k) X[PI((hi << 13) + lo + 1024 * k)] = x[k];
            }
            __syncthreads();
            fft_pass8<false>(X, 9, 2048); fft_pass8<false>(X, 6, 2048); fft_pass8<false>(X, 3, 2048);
            for (int g = tid; g < 4096; g += 512) { const int qa = PI(2 * g), qb = PI(8192 + 2 * g);
                const float2 a0 = X[qa], a1 = X[qa + 1], b0 = X[qb], b1 = X[qb + 1];
                const float2 as = make_float2(a0.x + a1.x, a0.y + a1.y), ad = make_float2(a0.x - a1.x, a0.y - a1.y), bs = make_float2(b0.x + b1.x, b0.y + b1.y), bd = make_float2(b0.x - b1.x, b0.y - b1.y);
                const float2 p0 = make_float2(as.x * bs.x - as.y * bs.y, as.x * bs.y + as.y * bs.x), p1 = make_float2(ad.x * bd.x - ad.y * bd.y, ad.x * bd.y + ad.y * bd.x);
                X[qb] = make_float2(p0.x + p1.x, p0.y + p1.y); X[qb + 1] = make_float2(p0.x - p1.x, p0.y - p1.y); }
            __syncthreads();
            fft_inv(X, 13, 1024, 8192, false, 9);
#pragma unroll
            for (int q = 0; q < 2; ++q) {
                const int lo = tid + q * 512;
                float2 x[8];
#pragma unroll
                for (int k = 0; k < 8; ++k) x[k] = X[PI(8192 + lo + 1024 * k)];
                bfly8<true>(x, (float)lo * (1.0f / 8192.0f));
#pragma unroll
                for (int k = 0; k < 4; ++k) { y0[lo + 1024 * k] = x[k].x * (1.0f / 8192.0f); y1[lo + 1024 * k] = x[k].y * (1.0f / 8192.0f); }
            }
            __syncthreads();
        } else {
            const int c = it - 1024; const float* kern = (const float*)(p.ws + B_KERN256) + (size_t)c * 512;
            X[PI(tid)] = make_float2(kern[tid], 0.f);
            {   float va[8], vb[8]; const int q = tid & 511;
#pragma unroll
                for (int pr = 0; pr < 8; ++pr) { const float* ya = VXT + (size_t)(2 * pr) * 256 * DM + (size_t)c * 256; const float* yb = ya + (size_t)256 * DM; va[pr] = q < 256 ? ya[q] : 0.f; vb[pr] = q < 256 ? yb[q] : 0.f; }
#pragma unroll
                for (int pr = 0; pr < 8; ++pr) X[PI(512 + pr * 512 + q)] = make_float2(va[pr], vb[pr]); }
            __syncthreads();
            fft_fwd(X, 9, 512 + 4096);
            for (int m = tid; m < 4096; m += 512) { const float2 a = X[PI(m & 511)], b = X[PI(512 + m)]; X[PI(512 + m)] = make_float2(a.x * b.x - a.y * b.y, a.x * b.y + a.y * b.x); }
            __syncthreads();
            fft_inv(X, 9, 64, 4096);
            for (int m = tid; m < 4096; m += 512) { const int pr = m >> 9, q = m & 511;
                if (q < 256) { float* ya = VXT + (size_t)(2 * pr) * 256 * DM + (size_t)c * 256; float* yb = ya + (size_t)256 * DM; const float2 b = X[PI(512 + m)]; ya[q] = b.x * (1.0f / 512.0f); yb[q] = b.y * (1.0f / 512.0f); } }
            __syncthreads();
        }
    }
}
__device__ __forceinline__ void phase_hyena_post(const Params& p, int l, unsigned char* shm) {
    const int tid = ltid(), j = l >> 1, G = (int)gridDim.x;
    float* tile = (float*)shm;
    const bf16_t* U = (const bf16_t*)(p.ws + B_U); const float* VXT = (const float*)(p.ws + B_VXT); bf16_t* H = (bf16_t*)(p.ws + OFF_H);
    const float* cw = p.in[I_HYCW] + (size_t)j * 3 * 3072; const float* cb = p.in[I_HYCB] + j * 3072;
    const int ch = tid & 63, tg = tid >> 6, r = tid >> 3, e0 = (tid & 7) * 8;
    float4 o0, o1; bf16_t xr[10];
#define HQ_LOAD(it_) do { const int it2 = (it_); const int tt0_ = (it2 >> 4) * 64, c0_ = (it2 & 15) * 64; int sb_, L_; tokinfo(tt0_, sb_, L_); \
        const float* src = VXT + (size_t)sb_ * DM + (size_t)(c0_ + r) * L_ + (tt0_ - sb_) + e0; o0 = *(const float4*)src; o1 = *(const float4*)(src + 4); \
        _Pragma("unroll") for (int e = 0; e < 10; ++e) { const int t = tt0_ + tg * 8 + e - 1; const bool ok = t >= sb_ && t < sb_ + L_; const bf16_t xv = U[(size_t)(ok ? t : tt0_) * 3072 + c0_ + ch]; xr[e] = ok ? xv : (bf16_t)0; } } while (0)
    if (lbid() < 3072) HQ_LOAD(lbid());
    for (int it = lbid(); it < 3072; it += G) {
        const int tt0 = (it >> 4) * 64, c0 = (it & 15) * 64;
        tile[r * 65 + e0] = o0.x; tile[r * 65 + e0 + 1] = o0.y; tile[r * 65 + e0 + 2] = o0.z; tile[r * 65 + e0 + 3] = o0.w;
        tile[r * 65 + e0 + 4] = o1.x; tile[r * 65 + e0 + 5] = o1.y; tile[r * 65 + e0 + 6] = o1.z; tile[r * 65 + e0 + 7] = o1.w;
        float x[10];
#pragma unroll
        for (int e = 0; e < 10; ++e) x[e] = bf2f(xr[e]);
        if (it + G < 3072) HQ_LOAD(it + G);
        __syncthreads();
        const int c = c0 + ch;
        const float w0 = cw[c], w1 = cw[3072 + c], w2 = cw[6144 + c], bb = cb[c];
#pragma unroll
        for (int e = 0; e < 8; ++e) { const float x0 = x[e] * w0 + x[e + 1] * w1 + x[e + 2] * w2 + bb;
            H[(size_t)(tt0 + tg * 8 + e) * DM + c] = f2bf(x0 * tile[ch * 65 + tg * 8 + e]); }
        __syncthreads();
    }
#undef HQ_LOAD
}

__device__ __forceinline__ void phase_ffn_act(const Params& p, int l, unsigned char* shm) {
    const bf16_t* GU = (const bf16_t*)(p.ws + B_GU); bf16_t* ACT = (bf16_t*)(p.ws + B_ACT);
    const int G = (int)gridDim.x, b0 = lbid();
    constexpr int BUFB = 4 * 66 * 128 * 2;
    constexpr int NIT = 1408 + 704;
    uint4 pr[8];
#define FA_ISSUE(it_) do { const int it2 = (it_); const int tid = ltid(); \
        if (it2 < 1408) { const int sq = it2 / 704, rg = (it2 % 704) / 22, cc = it2 % 22; const int sb = NCTX + sq * 4096; \
            _Pragma("unroll") for (int i = 0; i < 8; ++i) { const int idx = tid + i * 512, fgc = idx & 15, col = (idx >> 4) & 63, ri = idx >> 10; const int grow = rg * 2 - 1 + ri; const bool ok = grow >= 0 && grow < 64; \
                pr[i] = *(const uint4*)(GU + (size_t)(sb + (ok ? grow : 0) * 64 + col) * 5632 + cc * 128 + fgc * 8); if (!ok) pr[i] = make_uint4(0, 0, 0, 0); } \
        } else { const int r = it2 - 1408, sq = r / 44, hf = (r / 22) & 1, cc = r % 22; const int sb = sq * 256, t0 = sb + hf * 128; \
            _Pragma("unroll") for (int i = 0; i < 5; ++i) { const int idx = tid + i * 512, fgc = idx & 15, prow = idx >> 4; const int tok = t0 - 1 + prow; const bool ok = idx < 2080 && tok >= sb && tok < sb + 256; \
                pr[i] = *(const uint4*)(GU + (size_t)(ok ? tok : sb) * 5632 + cc * 128 + fgc * 8); if (!ok) pr[i] = make_uint4(0, 0, 0, 0); } } } while (0)
#define FA_STORE(it_, buf_) do { const int it2 = (it_); const int tid = ltid(); bf16_t* B_ = (bf16_t*)(shm + (buf_) * BUFB); \
        if (it2 < 1408) { \
            _Pragma("unroll") for (int i = 0; i < 8; ++i) { const int idx = tid + i * 512, fgc = idx & 15, col = (idx >> 4) & 63, ri = idx >> 10; *(uint4*)(B_ + ((ri * 66 + col + 1) * 128 + fgc * 8)) = pr[i]; } \
            if (tid < 128) { const int fgc = tid & 15, hc = (tid >> 4) & 1, ri = tid >> 5; *(uint4*)(B_ + ((ri * 66 + hc * 65) * 128 + fgc * 8)) = make_uint4(0, 0, 0, 0); } \
        } else { \
            _Pragma("unroll") for (int i = 0; i < 5; ++i) { const int idx = tid + i * 512, fgc = idx & 15, prow = idx >> 4; if (idx < 2080) *(uint4*)(B_ + (prow * 128 + fgc * 8)) = pr[i]; } } } while (0)
    int it = b0, cur = 0;
    if (it < NIT) { FA_ISSUE(it); FA_STORE(it, 0); }
    __syncthreads();
    for (; it < NIT; it += G) {
        const int tid = ltid(), fgc = tid & 15;
        const int nxt = it + G;
        const bf16_t* B_ = (const bf16_t*)(shm + cur * BUFB);
        const bool lat = it < 1408;
        int cc, tokbase;
        if (lat) { const int sq = it / 704, rg = (it % 704) / 22; cc = it % 22; tokbase = NCTX + sq * 4096 + rg * 128; }
        else { const int r = it - 1408, sq = r / 44, hf = (r / 22) & 1; cc = r % 22; tokbase = sq * 256 + hf * 128; }
        const int f0 = cc * 128 + fgc * 8;
        const float* cwp = p.in[I_FCONV] + (size_t)l * 9 * 2816 + f0;
        float bias[8];
        { const float4 a = *(const float4*)(p.in[I_FCB] + l * 2816 + f0), bq = *(const float4*)(p.in[I_FCB] + l * 2816 + f0 + 4);
          bias[0] = a.x; bias[1] = a.y; bias[2] = a.z; bias[3] = a.w; bias[4] = bq.x; bias[5] = bq.y; bias[6] = bq.z; bias[7] = bq.w; }
        uint4 upr[4];
#pragma unroll
        for (int i = 0; i < 4; ++i) { const int o = tid + i * 512; const int tok = tokbase + (o >> 4); upr[i] = *(const uint4*)(GU + (size_t)tok * 5632 + 2816 + f0); }
        float4 wq[9][2];
#pragma unroll
        for (int q = 0; q < 9; ++q) { wq[q][0] = *(const float4*)(cwp + q * 2816); wq[q][1] = *(const float4*)(cwp + q * 2816 + 4); }
        if (nxt < NIT) FA_ISSUE(nxt);
        float acc[4][8];
#pragma unroll
        for (int i = 0; i < 4; ++i)
#pragma unroll
            for (int e = 0; e < 8; ++e) acc[i][e] = bias[e];
#pragma unroll
        for (int q = 0; q < 9; ++q) {
            if (!lat && (q < 3 || q > 5)) continue;
            const float4 wa = wq[q][0], wb = wq[q][1];
            const float w[8] = {wa.x, wa.y, wa.z, wa.w, wb.x, wb.y, wb.z, wb.w};
            const int di = q / 3, dj = q % 3;
#pragma unroll
            for (int i = 0; i < 4; ++i) { const int o = tid + i * 512, pos = o >> 4;
                const int li = lat ? (((pos >> 6) + di) * 66 + (pos & 63) + dj) : (pos + dj);
                float x[8]; unpack8(*(const uint4*)(B_ + (li * 128 + fgc * 8)), x);
#pragma unroll
                for (int e = 0; e < 8; ++e) acc[i][e] += x[e] * w[e]; }
        }
#pragma unroll
        for (int i = 0; i < 4; ++i) { const int o = tid + i * 512; const int tok = tokbase + (o >> 4); float up[8]; unpack8(upr[i], up);
#pragma unroll
            for (int e = 0; e < 8; ++e) acc[i][e] = silu(acc[i][e]) * up[e];
            *(uint4*)(ACT + (size_t)tok * 2816 + f0) = pack8(acc[i]); }
        if (nxt < NIT) FA_STORE(nxt, cur ^ 1);
        __syncthreads();
        cur ^= 1;
    }
#undef FA_ISSUE
#undef FA_STORE
}

constexpr int NPHASE = 42;
#ifndef ONLY
#define ONLY -1
#endif
#define ON(id) (ONLY < 0 || ONLY == (id))
__device__ __forceinline__ void run_phase(const Params& p, int ph, unsigned char* shm) {
    int pr_lo = 0, pr_hi = 3072; if (ph >= 3000) { ph -= 3000; pr_lo = 1536; } else if (ph >= 2000) { ph -= 2000; pr_hi = 1536; }
    const bool dummy = ph >= 1000; if (dummy) ph -= 1000;
    float* const XR = dummy ? (float*)(p.ws + OFF_BIG + 200 * MB) : p.out;
    if (ph == 0) { if (ON(0)) phase_prologue(p, shm); return; }
    if (ph == NPHASE - 1) { if (ON(1)) norm_rows(p, 0, 2, shm); return; }
    const int l = (ph - 1) / 10, s = (ph - 1) % 10; const bool even = (l & 1) == 0; const int j = l >> 1;
    const float* MOD = (const float*)(p.ws + OFF_MOD);
    bf16_t* H = (bf16_t*)(p.ws + OFF_H);
    switch (s) {
    case 0: if (ON(2)) norm_rows(p, l, 0, shm); __syncthreads(); if (ON(2)) { if (!even) hyena_hid2(p, l, shm); } break;
    case 1: if (even && ON(3)) { EpiBf16S E; E.O1 = (bf16_t*)(p.ws + B_QKV); E.ld1 = 3072; E.nsplit = 12; E.O2 = (bf16_t*)(p.ws + B_ZG); E.ld2 = 1024; E.bias = nullptr;
                run_gemm(shm, H, (const bf16_t*)(p.ws + OFF_WIN), 4096, 1024, E); }
            else if (!even && ON(4)) { EpiBf16S E; E.O1 = (bf16_t*)(p.ws + B_U); E.ld1 = 3072; E.nsplit = 1000; E.O2 = nullptr; E.ld2 = 0; E.bias = p.in[I_HYBIN] + j * 3072;
                run_gemm(shm, H, (const bf16_t*)(p.ws + OFF_WIN), 3072, 1024, E);
                { const int G = (int)gridDim.x, b = lbid(); if (G > 64) { if (b >= 64) hyena_kern(p, l, shm, b - 64, G - 64); } else hyena_kern(p, l, shm, b, G); } }
            break;
    case 2: if (even) { if (ON(5)) phase_prep(p, l, shm, pr_lo, pr_hi, pr_lo != 0 || pr_hi != 3072); } else if (ON(6)) phase_hyena_pre(p, l, shm); break;
    case 3: if (even) { if (ON(7)) phase_scan(p, l, shm, pr_hi != 3072); } else if (ON(8)) phase_hyena_fft(p, l, shm); break;
    case 4: if (even) { if (ON(9)) phase_post(p, l, shm); } else if (ON(10)) phase_hyena_post(p, l, shm); break;
    case 5: if (ON(11)) { EpiRes E; E.X = XR; E.gate = MOD + (l * 3) * 6144 + 2048; E.bias = even ? nullptr : p.in[I_HYBOUT] + j * 1024;
              run_gemm(shm, H, (const bf16_t*)(p.ws + OFF_WOUT), 1024, 1024, E);
              if (!dummy) { const int G = (int)gridDim.x, b = lbid(); if (G > 192) { if (b >= 192) convert_ffn(p, l, shm, b - 192, G - 192); } else convert_ffn(p, l, shm, b, G); } } break;
    case 6: if (ON(12)) { norm_rows(p, l, 1, shm); } break;
    case 7: if (ON(13)) { EpiBf16S E; E.O1 = (bf16_t*)(p.ws + B_GU); E.ld1 = 5632; E.nsplit = 1000; E.O2 = nullptr; E.ld2 = 0; E.bias = nullptr;
              run_gemm(shm, H, (const bf16_t*)(p.ws + OFF_WGU), 5632, 1024, E); } break;
    case 8: if (ON(14)) phase_ffn_act(p, l, shm); break;
    case 9: if (ON(15)) { EpiRes E; E.X = XR; E.gate = MOD + (l * 3) * 6144 + 5120; E.bias = nullptr;
              run_gemm(shm, (const bf16_t*)(p.ws + B_ACT), (const bf16_t*)(p.ws + OFF_WDN), 1024, 2816, E);
              if (!dummy && l < 3) { const int G = (int)gridDim.x, b = lbid(); if (G > 192) { if (b >= 192) convert_mixer(p, l + 1, shm, b - 192, G - 192); } else convert_mixer(p, l + 1, shm, b, G); } } break;
    }
}

typedef const __attribute__((address_space(4))) Params* KP;
__global__ void __launch_bounds__(512, 2) mk_fwd(Params p) {
    extern __shared__ __attribute__((aligned(16))) unsigned char shm[];
    cg::grid_group grid = cg::this_grid();
    KP kp0 = (KP)__builtin_amdgcn_kernarg_segment_ptr();
    const int lo = p.lo, hi = p.hi;
    volatile LAS unsigned* st = (volatile LAS unsigned*)(shm + LDS_BYTES - 64);
    if (threadIdx.x < 2) st[threadIdx.x] = 0u;
    __syncthreads();
    XcdBarrier xb = xcd_barrier_post((unsigned*)(p.ws + OFF_BAR), st);
    for (int ph = lo; ph < hi; ++ph) {
        KP kp = kp0; asm volatile("" : "+s"(kp));
        run_phase(*(const Params*)kp, ph, shm);
#ifdef DUP_S
        if (ph >= 1 && ph < NPHASE - 1) { const int l_ = (ph - 1) / 10, s_ = (ph - 1) % 10;
            if ((l_ & 1) == DUP_PAR || DUP_PAR == 2) {
                if (DUP_S < 10 && s_ == DUP_S) { xcd_barrier(xb); KP kq = kp0; asm volatile("" : "+s"(kq)); run_phase(*(const Params*)kq, (DUP_S == 5 || DUP_S == 9) ? ph + 1000 : ph, shm); }
                if (DUP_S == 30 && s_ == 3) { xcd_barrier(xb); KP kq = kp0; asm volatile("" : "+s"(kq)); run_phase(*(const Params*)kq, ph + 2000, shm); }
                if ((DUP_S == 20 || DUP_S == 21) && s_ == 2) { xcd_barrier(xb); KP kq = kp0; asm volatile("" : "+s"(kq)); run_phase(*(const Params*)kq, ph + (DUP_S == 20 ? 2000 : 3000), shm); }
                if (DUP_S == 23 && s_ == 3) { xcd_barrier(xb); { KP kq = kp0; asm volatile("" : "+s"(kq)); run_phase(*(const Params*)kq, ph - 1, shm); } xcd_barrier(xb); { KP kq = kp0; asm volatile("" : "+s"(kq)); run_phase(*(const Params*)kq, ph, shm); } }
            } }
#endif
        if (ph + 1 < hi) { if (ph == 0) grid.sync(); else xcd_barrier(xb); }
    }
}

#ifndef MK_ONE_LAUNCH
#define MK_ONE_LAUNCH 1
#endif

extern "C" void kernel_launch(void* const* d_in, const int* in_sizes, int n_in, void* d_out, int out_size, void* d_ws, size_t ws_size, hipStream_t stream) {
    static int grid = 0;
    if (grid == 0) {
        if (n_in != N_IN || ws_size < WS_NEED) { fprintf(stderr, "kernel_launch: unexpected n_in %d or ws_size %zu (need %zu)\n", n_in, ws_size, (size_t)WS_NEED); grid = -1; return; }
        int dev = 0, cus = 0, per_cu = 0;
        hipGetDevice(&dev); hipDeviceGetAttribute(&cus, hipDeviceAttributeMultiprocessorCount, dev);
        if (hipFuncSetAttribute((const void*)mk_fwd, hipFuncAttributeMaxDynamicSharedMemorySize, LDS_BYTES) != hipSuccess) { fprintf(stderr, "kernel_launch: hipFuncSetAttribute failed\n"); grid = -1; return; }
        if (hipOccupancyMaxActiveBlocksPerMultiprocessor(&per_cu, (const void*)mk_fwd, 512, LDS_BYTES) != hipSuccess || per_cu < 1) { fprintf(stderr, "kernel_launch: occupancy query failed (%d)\n", per_cu); (void)hipGetLastError(); per_cu = 1; }
        grid = cus * 1;
        if (grid <= 0) grid = 256;
    }
    if (grid < 0) return;
    Params p{};
    for (int i = 0; i < N_IN; ++i) p.in[i] = (const float*)d_in[i];
    p.out = (float*)d_out; p.ws = (unsigned char*)d_ws;
#if MK_ONE_LAUNCH
    p.lo = 0; p.hi = NPHASE;
    if (hipMemsetAsync((char*)d_ws + OFF_BAR, 0, XCD_BAR_WORDS * sizeof(unsigned), stream) != hipSuccess) { fprintf(stderr, "kernel_launch: memset of barrier words failed\n"); return; }
    void* args[] = {&p};
    hipError_t e = hipLaunchCooperativeKernel((const void*)mk_fwd, dim3(grid), dim3(512), args, LDS_BYTES, stream);
    if (e != hipSuccess) fprintf(stderr, "cooperative launch failed: %s (grid %d)\n", hipGetErrorString(e), grid);
#else
#ifndef PROBE_NPH
#define PROBE_NPH NPHASE
#endif
    (void)hipMemsetAsync((char*)d_ws + OFF_BAR, 0, XCD_BAR_WORDS * sizeof(unsigned), stream);
    for (int ph = 0; ph < NPHASE; ++ph) { if (ph >= PROBE_NPH && ph != NPHASE - 1) continue; p.lo = ph; p.hi = ph + 1; hipLaunchKernelGGL(mk_fwd, dim3(grid), dim3(512), LDS_BYTES, stream, p); }
#endif
}
```

```cpp
#include <hip/hip_runtime.h>
#include <hip/hip_cooperative_groups.h>
#include <cstdio>
namespace cg = cooperative_groups;
__device__ __forceinline__ int ltid() { int t = threadIdx.x; asm volatile("" : "+v"(t)); return t; }
__device__ __forceinline__ int lbid() { int t = blockIdx.x; asm volatile("" : "+s"(t)); return t; }
#define LAS __attribute__((address_space(3)))
#define XB_TMO      128
#define XB_XCNT(j)  (256  + 64 * (j))
#define XB_XSUB(j)  (1280 + 64 * (j))
#define XB_XGEN(j)  (2304 + 64 * (j))
#define XB_TOP      3328
#define XB_TOPGEN   3392
#define XCD_BAR_WORDS 3456
#define XB_SPIN_CAP (1u << 18)
__device__ __forceinline__ unsigned xb_ld(unsigned* p)              { return __hip_atomic_load(p, __ATOMIC_RELAXED, __HIP_MEMORY_SCOPE_AGENT); }
__device__ __forceinline__ unsigned xb_add(unsigned* p, unsigned v) { return __hip_atomic_fetch_add(p, v, __ATOMIC_RELAXED, __HIP_MEMORY_SCOPE_AGENT); }
__device__ __forceinline__ unsigned xb_xcc_id() { return (unsigned)__builtin_amdgcn_s_getreg((3 << 11) | 20) & 0xFu; }
#define XB_SPIN(cond, bar) do { unsigned _sp = 0; while (cond) { __builtin_amdgcn_s_sleep(1); \
    if ((++_sp & 255u) == 0u) { if (xb_ld(&(bar)[XB_TMO])) break; if (_sp > XB_SPIN_CAP) { atomicAdd(&(bar)[XB_TMO], 1u); break; } } } } while (0)

struct XcdBarrier {
    unsigned* bar; unsigned x;
    volatile LAS unsigned* st;
};

__device__ __forceinline__ XcdBarrier xcd_barrier_post(unsigned* bar, volatile LAS unsigned* st) {
    XcdBarrier b; b.bar = bar; b.x = xb_xcc_id(); b.st = st;
    if (threadIdx.x == 0) (void)xb_add(&bar[XB_XCNT(b.x)], 1u);
    return b;
}
__device__ __forceinline__ void xcd_barrier_complete(unsigned* bar, unsigned x, unsigned& nloc, unsigned& nx) {
    const unsigned G = gridDim.x * gridDim.y * gridDim.z;
    unsigned sum, cnt, mine, sp = 0u;
    for (;;) {
        sum = 0u; cnt = 0u; mine = 0u;
#pragma unroll
        for (unsigned j = 0; j < 16; ++j) { const unsigned c = xb_ld(&bar[XB_XCNT(j)]); sum += c; cnt += (c > 0u) ? 1u : 0u; mine = (j == x) ? c : mine; }
        if (sum == G) break;
        __builtin_amdgcn_s_sleep(1);
        if ((++sp & 255u) == 0u) { if (xb_ld(&bar[XB_TMO])) break; if (sp > XB_SPIN_CAP) { atomicAdd(&bar[XB_TMO], 1u); break; } }
    }
    nloc = mine > 0u ? mine : 1u; nx = cnt > 0u ? cnt : 1u;
}

__device__ __forceinline__ void xcd_barrier(const XcdBarrier& b) {
    asm volatile("s_waitcnt vmcnt(0)" ::: "memory");
    __syncthreads();
    if (threadIdx.x == 0) {
        unsigned* bar = b.bar;
        __builtin_amdgcn_s_waitcnt(0);
        unsigned nloc = b.st[0], nx = b.st[1];
        if (nloc == 0u) { xcd_barrier_complete(bar, b.x, nloc, nx); b.st[0] = nloc; b.st[1] = nx; }
        const unsigned old = xb_add(&bar[XB_XSUB(b.x)], 1u);
        const unsigned gen = old / nloc;
        if (old + 1u == (gen + 1u) * nloc) {
            __builtin_amdgcn_fence(__ATOMIC_RELEASE, "agent");
            asm volatile("s_waitcnt vmcnt(0)" ::: "memory");
            const unsigned og = xb_add(&bar[XB_TOP], 1u);
            const unsigned tg = og / nx;
            if (og + 1u == (tg + 1u) * nx) xb_add(&bar[XB_TOPGEN], 1u);
            else XB_SPIN(xb_ld(&bar[XB_TOPGEN]) == tg, bar);
            __builtin_amdgcn_fence(__ATOMIC_ACQUIRE, "agent");
            xb_add(&bar[XB_XGEN(b.x)], 1u);
            asm volatile("s_waitcnt vmcnt(0)" ::: "memory");
        } else {
            XB_SPIN(xb_ld(&bar[XB_XGEN(b.x)]) == gen, bar);
            __builtin_amdgcn_fence(__ATOMIC_ACQUIRE, "agent");
            asm volatile("s_waitcnt vmcnt(0)" ::: "memory");
        }
    }
    __syncthreads();
}

#define XB_REC_WORDS 32
namespace pg8 {
#define PG8_LAS __attribute__((address_space(3)))
typedef unsigned short bf16_t;
typedef short bf16x8 __attribute__((ext_vector_type(8)));
typedef float f32x4 __attribute__((ext_vector_type(4)));
typedef unsigned u32x4 __attribute__((ext_vector_type(4)));
constexpr int BM = 256, BK = 64, HALF = 128, HTB = HALF * BK * 2  , STAGE_BYTES = 8 * HTB, NXCD = 8, WGM = 8;

__host__ __device__ __forceinline__ int lds_byte(int r, int c) { const int st = (r >> 4) * 2 + (c >> 5), rr = r & 15, cc = c & 31, ob = rr * 64 + cc * 2; return st * 1024 + (ob ^ (((ob >> 9) & 1) << 5)); }
__host__ __device__ __forceinline__ void stage_rc(int b, int& R, int& C) { const int st = b / 1024, sb = b % 1024, swz = sb ^ (((sb >> 9) & 1) << 5); R = (st >> 1) * 16 + swz / 64; C = (st & 1) * 32 + (swz % 64) / 2; }
__host__ __device__ __forceinline__ int perm32(int rho) { const int n = rho >> 4, i = rho & 15; return 8 * (i >> 2) + 4 * n + (i & 3); }

struct Unit { int pm, pn; };
struct Gemm { const bf16_t* A; const bf16_t* Bt; int M, N, K; };

struct StaticOrder {
    int nM, nN, nwg, G, c;
    __host__ __device__ void init(int M, int N, int G_, int c_) { nM = M / BM; nN = N / BM; nwg = nM * nN; G = G_; c = c_; }
    __host__ __device__ bool next(int i, Unit& u) const {
        const long L = (long)i * G + c; if (L >= nwg) return false;
        int wgid = (int)L; { const int q = nwg / NXCD, r = nwg % NXCD, xcd = wgid % NXCD, off = wgid / NXCD; wgid = (xcd < r ? xcd * (q + 1) : r * (q + 1) + (xcd - r) * q) + off; }
        const int nig = WGM * nN, gid = wgid / nig, fm = gid * WGM, gsz = (nM - fm) < WGM ? (nM - fm) : WGM;
        u.pm = fm + ((wgid % nig) % gsz); u.pn = (wgid % nig) / gsz; return true;
    }
    __device__ __forceinline__ void a_ready(const Unit&) const {}
    __device__ __forceinline__ void done(const Unit&) const {}
};
__device__ __forceinline__ unsigned cvt_pk_bf16(float lo, float hi) {
    typedef __bf16 bf2_t __attribute__((ext_vector_type(2))); typedef float f2_t __attribute__((ext_vector_type(2)));
    f2_t v = {lo, hi}; bf2_t r = __builtin_convertvector(v, bf2_t); return __builtin_bit_cast(unsigned, r); }
typedef float f32x2 __attribute__((ext_vector_type(2)));
template <class Epi, class Sched, bool STAMP = false>
__device__ __forceinline__ void gemm_phase(PG8_LAS unsigned char* lds, const Gemm g, const Sched& S, const Epi& E, unsigned long long* stamps) {
    const int tid = ltid(), wid = __builtin_amdgcn_readfirstlane(tid >> 6), lane = tid & 63, wr = wid >> 2, wc = wid & 3, fr = lane & 15, fq = lane >> 4;
    const int K = g.K, nt = K / BK;
    int ts_lo = 0, ts_hi = 0, nts = 0; const unsigned long long rt_entry = STAMP ? (unsigned long long)wall_clock64() : 0ull;
#define PG8_STAMP() do { if (STAMP && wid == 0 && nts < 64) { const unsigned long long _c = (unsigned long long)clock64(); \
        ts_lo = (lane == nts) ? (int)(unsigned)_c : ts_lo; ts_hi = (lane == nts) ? (int)(unsigned)(_c >> 32) : ts_hi; ++nts; } } while (0)
    PG8_STAMP();
    unsigned voffA[2], voffB[2];
#pragma unroll
    for (int i = 0; i < 2; ++i) { int R, C; stage_rc(tid * 16 + i * 8192, R, C); const int Rb = Epi::PERM ? ((R & ~31) + perm32(R & 31)) : R;
        voffA[i] = (unsigned)(R * K + C) * 2u; voffB[i] = (unsigned)(Rb * K + C) * 2u; }
    const size_t kstep = (size_t)(BK * 2);
    const size_t hstep = (size_t)HALF * K * 2;
    const size_t tstep = 2 * hstep;
    const unsigned ldsw = (unsigned)wid * 1024u;
    const int aoff = lds_byte(wr * 64 + fr, fq * 8), boff = lds_byte(wc * 32 + fr, fq * 8);
#define PG8_SA(b, h) (((b) * 2 + (h)) * HTB)
#define PG8_SB(b, h) ((4 + (b) * 2 + (h)) * HTB)
#define PG8_STAGE(bufoff, gbase, voff) do { _Pragma("unroll") for (int _i = 0; _i < 2; ++_i) \
        __builtin_amdgcn_global_load_lds((const unsigned*)((const char*)(gbase) + (voff)[_i]), (PG8_LAS unsigned*)(lds + (bufoff) + ldsw + _i * 8192), 16, 0, 0); } while (0)
#define PG8_LDA(dst, b, h) do { _Pragma("unroll") for (int m = 0; m < 4; ++m) _Pragma("unroll") for (int k = 0; k < 2; ++k) dst[m][k] = *(const PG8_LAS bf16x8*)(lds + PG8_SA(b, h) + aoff + m * 2048 + k * 1024); } while (0)
#define PG8_LDB(dst, b, h) do { _Pragma("unroll") for (int n = 0; n < 2; ++n) _Pragma("unroll") for (int k = 0; k < 2; ++k) dst[n][k] = *(const PG8_LAS bf16x8*)(lds + PG8_SB(b, h) + boff + n * 2048 + k * 1024); } while (0)
#define PG8_MMA(ai, bj, At, Bt) do { __builtin_amdgcn_s_setprio(1); _Pragma("unroll") for (int m = 0; m < 4; ++m) _Pragma("unroll") for (int n = 0; n < 2; ++n) _Pragma("unroll") for (int k = 0; k < 2; ++k) \
        acc[ai][bj][m][n] = __builtin_amdgcn_mfma_f32_16x16x32_bf16(Bt[n][k], At[m][k], acc[ai][bj][m][n], 0, 0, 0); __builtin_amdgcn_s_setprio(0); } while (0)
#define PG8_WAIT_V(n) asm volatile("s_waitcnt vmcnt(" #n ")" ::: "memory")
#define PG8_WAIT_L(n) asm volatile("s_waitcnt lgkmcnt(" #n ")" ::: "memory")
#define PG8_BAR __builtin_amdgcn_s_barrier()
#define PG8_SCHED __builtin_amdgcn_sched_barrier(0)
    Unit cur, nxt; int ui = 0;
    if (!S.next(0, cur)) return;
    f32x4 acc[2][2][4][2];
#pragma unroll
    for (int a = 0; a < 2; ++a)
#pragma unroll
        for (int b = 0; b < 2; ++b)
#pragma unroll
            for (int m = 0; m < 4; ++m)
#pragma unroll
                for (int n = 0; n < 2; ++n) acc[a][b][m][n] = (f32x4){0.f, 0.f, 0.f, 0.f};
    bf16x8 At[4][2], B0[2][2], B1[2][2];
    const char* cA = (const char*)g.A + (size_t)cur.pm * tstep; const char* cB = (const char*)g.Bt + (size_t)cur.pn * tstep;
    S.a_ready(cur);
    PG8_STAGE(PG8_SB(0, 0), cB, voffB); PG8_STAGE(PG8_SA(0, 0), cA, voffA); PG8_STAGE(PG8_SB(0, 1), cB + hstep, voffB); PG8_STAGE(PG8_SA(0, 1), cA + hstep, voffA);
    if (wr == 1) PG8_BAR;
    PG8_WAIT_V(4); PG8_BAR;
    PG8_STAGE(PG8_SB(1, 0), cB + kstep, voffB); PG8_STAGE(PG8_SA(1, 0), cA + kstep, voffA); PG8_STAGE(PG8_SB(1, 1), cB + hstep + kstep, voffB);
    PG8_WAIT_V(6); PG8_BAR;
    PG8_STAMP();
    for (;;) {
        const bool has_next = S.next(ui + 1, nxt);
        const char* nA = has_next ? (const char*)g.A + (size_t)nxt.pm * tstep : cA; const char* nB = has_next ? (const char*)g.Bt + (size_t)nxt.pn * tstep : cB;
        for (int t = 0; t < nt; t += 2) {
            const bool last = (t == nt - 2);
            const char* a1 = cA + (size_t)(t + 1) * kstep;
            const char* a2 = last ? nA : cA + (size_t)(t + 2) * kstep; const char* b2 = last ? nB : cB + (size_t)(t + 2) * kstep;
            const char* a3 = a2 + kstep; const char* b3 = b2 + kstep;
            if (last && has_next) S.a_ready(nxt);
            PG8_LDB(B0, 0, 0); PG8_SCHED; PG8_LDA(At, 0, 0); PG8_STAGE(PG8_SA(1, 1), a1 + hstep, voffA);
            PG8_WAIT_L(8); PG8_BAR; PG8_WAIT_L(0); PG8_MMA(0, 0, At, B0); PG8_BAR; PG8_SCHED;
            PG8_LDB(B1, 0, 1); PG8_STAGE(PG8_SB(0, 0), b2, voffB);
            PG8_BAR; PG8_WAIT_L(0); PG8_MMA(0, 1, At, B1); PG8_BAR;
            PG8_LDA(At, 0, 1); PG8_STAGE(PG8_SA(0, 0), a2, voffA);
            PG8_BAR; PG8_WAIT_L(0); PG8_MMA(1, 0, At, B0); PG8_BAR; PG8_SCHED;
            PG8_STAGE(PG8_SB(0, 1), b2 + hstep, voffB);
            PG8_WAIT_V(6); PG8_BAR; PG8_MMA(1, 1, At, B1); PG8_BAR;
            PG8_LDB(B0, 1, 0); PG8_SCHED; PG8_LDA(At, 1, 0); PG8_STAGE(PG8_SA(0, 1), a2 + hstep, voffA);
            PG8_WAIT_L(8); PG8_BAR; PG8_WAIT_L(0); PG8_MMA(0, 0, At, B0); PG8_BAR; PG8_SCHED;
            PG8_LDB(B1, 1, 1); PG8_STAGE(PG8_SB(1, 0), b3, voffB);
            PG8_BAR; PG8_WAIT_L(0); PG8_MMA(0, 1, At, B1); PG8_BAR;
            PG8_LDA(At, 1, 1); PG8_STAGE(PG8_SA(1, 0), a3, voffA);
            PG8_BAR; PG8_WAIT_L(0); PG8_MMA(1, 0, At, B0); PG8_BAR; PG8_SCHED;
            PG8_STAGE(PG8_SB(1, 1), b3 + hstep, voffB);
            PG8_WAIT_V(6); PG8_BAR; PG8_MMA(1, 1, At, B1); PG8_BAR;
        }
        PG8_STAMP();
        if constexpr (!Epi::AFTER_DRAIN) { E(acc, cur, wr, wc, fr, fq); S.done(cur); }
        PG8_STAMP();
        if (!has_next) break;
#pragma unroll
        for (int a = 0; a < 2; ++a)
#pragma unroll
            for (int b = 0; b < 2; ++b)
#pragma unroll
                for (int m = 0; m < 4; ++m)
#pragma unroll
                    for (int n = 0; n < 2; ++n) acc[a][b][m][n] = (f32x4){0.f, 0.f, 0.f, 0.f};
        cur = nxt; cA = nA; cB = nB; ++ui;
    }
    PG8_WAIT_V(0);
    if (wr == 0) PG8_BAR;
    PG8_BAR;
    if constexpr (Epi::AFTER_DRAIN) { E.fused(acc, cur, wr, wc, fr, fq, lds, wid, lane); S.done(cur); }
    PG8_STAMP();
    if (STAMP && wid == 0) { stamps[lane] = lane < nts ? (((unsigned long long)(unsigned)ts_hi << 32) | (unsigned)ts_lo) : 0ull;
        if (lane == 62) stamps[62] = rt_entry; if (lane == 63) stamps[63] = (unsigned long long)wall_clock64(); }
#undef PG8_STAMP
#undef PG8_SA
#undef PG8_SB
#undef PG8_STAGE
#undef PG8_LDA
#undef PG8_LDB
#undef PG8_MMA
#undef PG8_WAIT_V
#undef PG8_WAIT_L
#undef PG8_BAR
#undef PG8_SCHED
}
}

using pg8::bf16_t; using pg8::bf16x8; using pg8::f32x4; using pg8::u32x4; using pg8::cvt_pk_bf16;

constexpr int NTOK = 12288, DM = 1024, NCTX = 4096;
constexpr size_t MB = 1048576;
constexpr size_t OFF_WIN = 0, OFF_WOUT = 8 * MB, OFF_WGU = 10 * MB, OFF_WDN = 21 * MB, OFF_H = 27 * MB, OFF_MOD = 51 * MB, OFF_SIDE = 52 * MB,
                 OFF_HID2 = 53 * MB, OFF_GL = 54 * MB + MB / 2, OFF_BIG = 55 * MB;
constexpr size_t B_QKV = OFF_BIG, B_ZG = OFF_BIG + 72 * MB, B_PREPD = OFF_BIG + 96 * MB, B_PREPR = B_PREPD + 108 * MB, B_ODIR = OFF_BIG;
constexpr size_t B_U = OFF_BIG, B_VXT = OFF_BIG + 72 * MB, B_KERN = OFF_BIG + 120 * MB, B_KERN256 = B_KERN + 32 * MB;
constexpr size_t B_GU = OFF_BIG, B_ACT = OFF_BIG + 132 * MB;
constexpr size_t WS_NEED = 343 * MB;
constexpr size_t OFF_BAR = 54 * MB + 3 * MB / 4;
constexpr int LDS_BYTES = 144 * 1024;
constexpr int ITEM_D = 73728, ITEM_R = 57344;
constexpr int PO_QD = 0, PO_KDT = 8192, PO_ATT = 16384, PO_U = 20480, PO_W = 28672;

enum { I_XP = 0, I_XS, I_SD, I_SR, I_C, I_CCTX, I_MODW, I_MODB, I_NORM1, I_NORM2, I_ABWIN, I_ABCONV, I_ALOG, I_DTB, I_NA, I_NB, I_RDEC, I_ABWOUT,
       I_HYWIN, I_HYBIN, I_HYCW, I_HYCB, I_FW1, I_FB1, I_FF1, I_FW2, I_FB2, I_FF2, I_FW3, I_FBIAS, I_HYWOUT, I_HYBOUT, I_FG, I_FU, I_FCONV, I_FCB, I_FD, I_FNORM, N_IN };

struct Params { const float* in[N_IN]; float* out; unsigned char* ws; int lo, hi; };

__device__ __forceinline__ float shx(float v, int m, int lane) { return __int_as_float(__builtin_amdgcn_ds_bpermute((lane ^ m) << 2, __float_as_int(v))); }
__device__ __forceinline__ float wsum(float v, int lane) {
#pragma unroll
    for (int o = 32; o; o >>= 1) v += shx(v, o, lane);
    return v; }
__device__ __forceinline__ bf16_t f2bf(float f) { return (bf16_t)(cvt_pk_bf16(f, 0.f) & 0xffffu); }
__device__ __forceinline__ float bf2f(bf16_t b) { return __uint_as_float(((unsigned)b) << 16); }
__device__ __forceinline__ float bflo(unsigned u) { return __uint_as_float(u << 16); }
__device__ __forceinline__ float bfhi(unsigned u) { return __uint_as_float(u & 0xffff0000u); }
__device__ __forceinline__ float silu(float x) { return x / (1.0f + __expf(-x)); }
__device__ __forceinline__ void tokinfo(int tok, int& sbase, int& L) { if (tok < NCTX) { sbase = tok & ~255; L = 256; } else { sbase = NCTX + ((tok - NCTX) & ~4095); L = 4096; } }
__device__ __forceinline__ void unpack8(const uint4 u, float* f) { f[0] = bflo(u.x); f[1] = bfhi(u.x); f[2] = bflo(u.y); f[3] = bfhi(u.y); f[4] = bflo(u.z); f[5] = bfhi(u.z); f[6] = bflo(u.w); f[7] = bfhi(u.w); }
__device__ __forceinline__ uint4 pack8(const float* f) { uint4 u; u.x = cvt_pk_bf16(f[0], f[1]); u.y = cvt_pk_bf16(f[2], f[3]); u.z = cvt_pk_bf16(f[4], f[5]); u.w = cvt_pk_bf16(f[6], f[7]); return u; }

struct EpiBf16S {
    static constexpr bool PERM = true, AFTER_DRAIN = false;
    bf16_t* O1; int ld1; int nsplit; bf16_t* O2; int ld2; const float* bias;
    __device__ __forceinline__ void operator()(const f32x4 (&acc)[2][2][4][2], const pg8::Unit& u, int wr, int wc, int fr, int fq) const {
        const int row0 = u.pm * 256 + wr * 64 + fr; bf16_t* base; int ldc, colt;
        if (u.pn < nsplit) { base = O1; ldc = ld1; colt = u.pn * 256; } else { base = O2; ldc = ld2; colt = (u.pn - nsplit) * 256; }
        const int col0 = colt + wc * 32 + 8 * fq, bcol0 = u.pn * 256 + wc * 32 + 8 * fq;
#pragma unroll
        for (int bj = 0; bj < 2; ++bj) {
            f32x4 b0 = {0.f, 0.f, 0.f, 0.f}, b1 = {0.f, 0.f, 0.f, 0.f};
            if (bias) { b0 = *(const f32x4*)(bias + bcol0 + bj * 128); b1 = *(const f32x4*)(bias + bcol0 + bj * 128 + 4); }
#pragma unroll
            for (int ai = 0; ai < 2; ++ai)
#pragma unroll
                for (int m = 0; m < 4; ++m) {
                    bf16_t* rowp = base + (size_t)(row0 + ai * 128 + m * 16) * ldc + col0 + bj * 128;
                    f32x4 v0 = acc[ai][bj][m][0] + b0, v1 = acc[ai][bj][m][1] + b1;
                    u32x4 w; w.x = cvt_pk_bf16(v0[0], v0[1]); w.y = cvt_pk_bf16(v0[2], v0[3]); w.z = cvt_pk_bf16(v1[0], v1[1]); w.w = cvt_pk_bf16(v1[2], v1[3]);
                    *(u32x4*)rowp = w; }
        }
    }
};
struct EpiRes {
    static constexpr bool PERM = false, AFTER_DRAIN = false;
    float* X; const float* gate; const float* bias; const float* XinC; const float* XinL;
    __device__ __forceinline__ void operator()(const f32x4 (&acc)[2][2][4][2], const pg8::Unit& u, int wr, int wc, int fr, int fq) const {
        const int row0 = u.pm * 256 + wr * 64 + fr, col0 = u.pn * 256 + wc * 32 + 4 * fq;
        const int vec = (u.pm < 16) ? 0 : 1 + ((u.pm - 16) >> 4);
        const float* Xin = (u.pm < 16) ? XinC : XinL;
        const float* g = gate + vec * 6144;
#pragma unroll
        for (int bj = 0; bj < 2; ++bj)
#pragma unroll
            for (int n = 0; n < 2; ++n) {
                const int c = col0 + bj * 128 + n * 16;
                const f32x4 gv = *(const f32x4*)(g + c);
                f32x4 bv = {0.f, 0.f, 0.f, 0.f}; if (bias) bv = *(const f32x4*)(bias + c);
                float* px = X + (size_t)row0 * DM + c; const float* pin = Xin + (size_t)row0 * DM + c;
                f32x4 xv[8];
#pragma unroll
                for (int q = 0; q < 8; ++q) xv[q] = __builtin_nontemporal_load((const f32x4*)(pin + (size_t)((q >> 2) * 128 + (q & 3) * 16) * DM));
#pragma unroll
                for (int q = 0; q < 8; ++q) xv[q] += gv * (acc[q >> 2][bj][q & 3][n] + bv);
#pragma unroll
                for (int q = 0; q < 8; ++q) *(f32x4*)(px + (size_t)((q >> 2) * 128 + (q & 3) * 16) * DM) = xv[q];
            }
    }
};

template <class Epi> __device__ __forceinline__ void run_gemm(unsigned char* shm, const bf16_t* A, const bf16_t* Bt, int N, int K, const Epi& E) {
    pg8::Gemm g; g.A = A; g.Bt = Bt; g.M = NTOK; g.N = N; g.K = K;
    pg8::StaticOrder S; S.init(NTOK, N, (int)gridDim.x, lbid());
    pg8::gemm_phase<Epi, pg8::StaticOrder, false>((PG8_LAS unsigned char*)shm, g, S, E, nullptr);
}

__device__ __forceinline__ void conv_seg(const float* __restrict__ src, int ld, int K, int col0, int ncols, bf16_t* __restrict__ dst, int& base, float* tile, int vb, int G) {
    const int nkt = K >> 6, n = nkt * (ncols >> 7);
    const int start = (vb - base % G + G) % G;
    const int tid0 = ltid(); const int n4 = (tid0 & 31) * 4, kk0 = tid0 >> 5;
    float4 v[4];
#define CV_LOAD(it_) do { const int kt_ = (it_) % nkt, ct_ = (it_) / nkt; const float* s_ = src + (size_t)(kt_ * 64) * ld + col0 + ct_ * 128; \
        _Pragma("unroll") for (int i = 0; i < 4; ++i) { const f32x4 t_ = __builtin_nontemporal_load((const f32x4*)(s_ + (size_t)(kk0 + 16 * i) * ld + n4)); v[i] = make_float4(t_[0], t_[1], t_[2], t_[3]); } } while (0)
    if (start < n) CV_LOAD(start);
    for (int it = start; it < n; it += G) {
        const int kt = it % nkt, ct = it / nkt;
#pragma unroll
        for (int i = 0; i < 4; ++i) { float* tp = tile + (kk0 + 16 * i) * 129 + n4; tp[0] = v[i].x; tp[1] = v[i].y; tp[2] = v[i].z; tp[3] = v[i].w; }
        if (it + G < n) CV_LOAD(it + G);
        __syncthreads();
        const int kc = tid0 & 7, nn = tid0 >> 3;
#pragma unroll
        for (int i = 0; i < 2; ++i) { const int c = nn + 64 * i; float f[8];
#pragma unroll
            for (int e = 0; e < 8; ++e) f[e] = tile[(kc * 8 + e) * 129 + c];
            *(uint4*)(dst + (size_t)(ct * 128 + c) * K + kt * 64 + kc * 8) = pack8(f); }
        __syncthreads();
    }
#undef CV_LOAD
    base += n;
}
__device__ __forceinline__ void convert_mixer(const Params& p, int l, unsigned char* shm, int vb, int nb) {
    float* tile = (float*)shm; int base = 0; const int j = l >> 1;
    bf16_t* win = (bf16_t*)(p.ws + OFF_WIN); bf16_t* wout = (bf16_t*)(p.ws + OFF_WOUT);
    if ((l & 1) == 0) {
        const float* w = p.in[I_ABWIN] + (size_t)j * 1024 * 4112;
        conv_seg(w, 4112, 1024, 0, 1536, win, base, tile, vb, nb);
        conv_seg(w, 4112, 1024, 2064, 1536, win + (size_t)1536 * 1024, base, tile, vb, nb);
        conv_seg(w, 4112, 1024, 1536, 512, win + (size_t)3072 * 1024, base, tile, vb, nb);
        conv_seg(w, 4112, 1024, 3600, 512, win + (size_t)3584 * 1024, base, tile, vb, nb);
        conv_seg(p.in[I_ABWOUT] + (size_t)j * 1024 * 1024, 1024, 1024, 0, 1024, wout, base, tile, vb, nb);
    } else {
        conv_seg(p.in[I_HYWIN] + (size_t)j * 1024 * 3072, 3072, 1024, 0, 3072, win, base, tile, vb, nb);
        conv_seg(p.in[I_HYWOUT] + (size_t)j * 1024 * 1024, 1024, 1024, 0, 1024, wout, base, tile, vb, nb);
    }
}
__device__ __forceinline__ void convert_ffn(const Params& p, int l, unsigned char* shm, int vb, int nb) {
    float* tile = (float*)shm; int base = 0;
    bf16_t* wgu = (bf16_t*)(p.ws + OFF_WGU); bf16_t* wdn = (bf16_t*)(p.ws + OFF_WDN);
    conv_seg(p.in[I_FG] + (size_t)l * 1024 * 2816, 2816, 1024, 0, 2816, wgu, base, tile, vb, nb);
    conv_seg(p.in[I_FU] + (size_t)l * 1024 * 2816, 2816, 1024, 0, 2816, wgu + (size_t)2816 * 1024, base, tile, vb, nb);
    conv_seg(p.in[I_FD] + (size_t)l * 2816 * 1024, 1024, 2816, 0, 1024, wdn, base, tile, vb, nb);
}

__device__ __forceinline__ void phase_prologue(const Params& p, unsigned char* shm) {
    const int tid = ltid(), G = (int)gridDim.x;
    float* sv = (float*)shm; float* red = sv + 3072;
    for (int i = tid; i < 3072; i += 512) { const int v = i >> 10, k = i & 1023; const float x = v == 0 ? p.in[I_CCTX][k] : p.in[I_C][(v - 1) * 1024 + k]; sv[i] = silu(x); }
    __syncthreads();
    float* MOD = (float*)(p.ws + OFF_MOD);
    for (int it = lbid(); it < 768; it += G) {
        const int l = it / 192, cb = (it % 192) * 32, cl = tid & 31, kg = tid >> 5;
        const float* w = p.in[I_MODW] + (size_t)l * 1024 * 6144 + cb + cl;
        float a0 = 0.f, a1 = 0.f, a2 = 0.f;
#pragma unroll 16
        for (int k = kg * 64; k < kg * 64 + 64; ++k) { const float wv = __builtin_nontemporal_load(w + (size_t)k * 6144); a0 += sv[k] * wv; a1 += sv[1024 + k] * wv; a2 += sv[2048 + k] * wv; }
        red[(0 * 16 + kg) * 32 + cl] = a0; red[(1 * 16 + kg) * 32 + cl] = a1; red[(2 * 16 + kg) * 32 + cl] = a2;
        __syncthreads();
        if (tid < 96) { const int v = tid >> 5, c = tid & 31; float s = 0.f;
#pragma unroll
            for (int q = 0; q < 16; ++q) s += red[(v * 16 + q) * 32 + c];
            MOD[(l * 3 + v) * 6144 + cb + c] = s + p.in[I_MODB][l * 6144 + cb + c]; }
        __syncthreads();
    }
    convert_mixer(p, 0, shm, lbid(), (int)gridDim.x);
}

__device__ __forceinline__ void norm_rows(const Params& p, int l, int which, unsigned char* shm) {
    const int tid = ltid(), lane = tid & 63, wid = tid >> 6;
    const float* nw = which == 0 ? p.in[I_NORM1] + l * 1024 : which == 1 ? p.in[I_NORM2] + l * 1024 : p.in[I_FNORM];
    const bool side = (which == 0) && ((l & 1) == 0);
    float* w16 = (float*)shm;
    if (side) {
        const float* w = p.in[I_ABWIN] + (size_t)(l >> 1) * 1024 * 4112 + 2048;
#pragma unroll 4
        for (int i0 = 0; i0 < 8; ++i0) { float4 v4[1]; const int f = tid + i0 * 512;
            const int k = f >> 2, qd = f & 3; v4[0] = *(const float4*)(w + (size_t)k * 4112 + qd * 4);
            const int slot = ((k >> 8) * 4 + (k & 3)) * 64 + ((k >> 2) & 63); *(float4*)(w16 + slot * 16 + qd * 4) = v4[0]; }
        __syncthreads();
    }
    const float* MOD = (const float*)(p.ws + OFF_MOD);
    bf16_t* H = (bf16_t*)(p.ws + OFF_H); float* SIDE = (float*)(p.ws + OFF_SIDE);
    const int rstride = (int)gridDim.x * 8;
    int row = lbid() * 8 + wid;
    float4 vn[4];
    const bool fromin = (which == 0 && l == 0);
#define NR_SRC(r_) (fromin ? ((r_) < NCTX ? p.in[I_XP] + (size_t)(r_) * DM : p.in[I_XS] + (size_t)((r_) - NCTX) * DM) : (const float*)p.out + (size_t)(r_) * DM)
    if (row < NTOK) {
#pragma unroll
        for (int i = 0; i < 4; ++i) vn[i] = *(const float4*)(NR_SRC(row) + i * 256 + lane * 4); }
    for (; row < NTOK; row += rstride) {
        float* xr = p.out + (size_t)row * DM;
        float4 v[4]; float ss = 0.f;
        const int vec = row < NCTX ? 0 : 1 + ((row - NCTX) >> 12);
        const float* md = MOD + (l * 3 + vec) * 6144 + (which == 1 ? 3072 : 0);
        float4 g4[4], sh4[4], sc4[4];
#pragma unroll
        for (int i = 0; i < 4; ++i) { g4[i] = *(const float4*)(nw + i * 256 + lane * 4); if (which != 2) { sh4[i] = *(const float4*)(md + i * 256 + lane * 4); sc4[i] = *(const float4*)(md + 1024 + i * 256 + lane * 4); } }
#pragma unroll
        for (int i = 0; i < 4; ++i) { v[i] = vn[i]; ss += v[i].x * v[i].x + v[i].y * v[i].y + v[i].z * v[i].z + v[i].w * v[i].w; }
        if (row + rstride < NTOK) {
#pragma unroll
            for (int i = 0; i < 4; ++i) vn[i] = *(const float4*)(NR_SRC(row + rstride) + i * 256 + lane * 4); }
        ss = wsum(ss, lane);
        const float r = rsqrtf(ss * (1.0f / 1024.0f) + 1e-6f);
        if (which == 2) {
#pragma unroll
            for (int i = 0; i < 4; ++i) { const float4 g = g4[i];
                float4 y; y.x = v[i].x * r * g.x; y.y = v[i].y * r * g.y; y.z = v[i].z * r * g.z; y.w = v[i].w * r * g.w; *(float4*)(xr + i * 256 + lane * 4) = y; }
        } else {
            float sacc[16];
#pragma unroll
            for (int q = 0; q < 16; ++q) sacc[q] = 0.f;
#pragma unroll
            for (int i = 0; i < 4; ++i) { const int k = i * 256 + lane * 4;
                const float4 g = g4[i], sh = sh4[i], sc = sc4[i];
                float hv[4]; hv[0] = v[i].x * r * g.x * (1.f + sc.x) + sh.x; hv[1] = v[i].y * r * g.y * (1.f + sc.y) + sh.y; hv[2] = v[i].z * r * g.z * (1.f + sc.z) + sh.z; hv[3] = v[i].w * r * g.w * (1.f + sc.w) + sh.w;
                uint2 pk; pk.x = cvt_pk_bf16(hv[0], hv[1]); pk.y = cvt_pk_bf16(hv[2], hv[3]);
                *(uint2*)(H + (size_t)row * DM + k) = pk;
                if (side) {
#pragma unroll
                    for (int e = 0; e < 4; ++e) { const float4* wp = (const float4*)(w16 + ((i * 4 + e) * 64 + lane) * 16);
#pragma unroll
                        for (int q = 0; q < 4; ++q) { const float4 wv = wp[q]; sacc[q * 4 + 0] += hv[e] * wv.x; sacc[q * 4 + 1] += hv[e] * wv.y; sacc[q * 4 + 2] += hv[e] * wv.z; sacc[q * 4 + 3] += hv[e] * wv.w; } }
                }
            }
            if (side) {
                const bool b5 = lane & 32, b4 = lane & 16, b3 = lane & 8, b2 = lane & 4;
                float t8[8], t4[4], t2[2];
#pragma unroll
                for (int i = 0; i < 8; ++i) { const float snd = b5 ? sacc[i] : sacc[i + 8], kp = b5 ? sacc[i + 8] : sacc[i]; t8[i] = kp + shx(snd, 32, lane); }
#pragma unroll
                for (int i = 0; i < 4; ++i) { const float snd = b4 ? t8[i] : t8[i + 4], kp = b4 ? t8[i + 4] : t8[i]; t4[i] = kp + shx(snd, 16, lane); }
#pragma unroll
                for (int i = 0; i < 2; ++i) { const float snd = b3 ? t4[i] : t4[i + 2], kp = b3 ? t4[i + 2] : t4[i]; t2[i] = kp + shx(snd, 8, lane); }
                float t1 = (b2 ? t2[1] : t2[0]) + shx(b2 ? t2[0] : t2[1], 4, lane);
                t1 += shx(t1, 2, lane); t1 += shx(t1, 1, lane);
                if ((lane & 3) == 0) SIDE[(size_t)row * 16 + ((lane >> 5) & 1) * 8 + ((lane >> 4) & 1) * 4 + ((lane >> 3) & 1) * 2 + ((lane >> 2) & 1)] = t1;
            }
        }
    }
}

__device__ __forceinline__ void hyena_hid2(const Params& p, int l, unsigned char* shm) {
    const int tid = ltid(), j = l >> 1;
    float* zf = (float*)shm;
    float* h1 = zf + 8 * 36;
    const float* w1 = p.in[I_FW1] + j * 33 * 64; const float* b1 = p.in[I_FB1] + j * 64; const float* f1 = p.in[I_FF1] + j * 64;
    const float* w2 = p.in[I_FW2] + j * 64 * 64; const float* b2 = p.in[I_FB2] + j * 64; const float* f2 = p.in[I_FF2] + j * 64;
    float* HID2 = (float*)(p.ws + OFF_HID2);
    for (int it = lbid(); it < 544; it += (int)gridDim.x) {
        const int row0 = it * 8;
        if (tid < 8 * 33) { const int r = tid / 33, e = tid % 33; const int rg = row0 + r; const int L = rg < 4096 ? 4096 : 256; const int i = rg < 4096 ? rg : rg - 4096;
            float val;
            if (e == 0) val = (float)i / (float)(L - 1);
            else { const int kb = (e - 1) & 15; const float band = 1e-4f + (float)kb * 0.99999333f; float rr = band * (float)i / (float)L; rr -= floorf(rr);
                val = (e <= 16) ? __builtin_amdgcn_cosf(rr) : -__builtin_amdgcn_sinf(rr); }
            zf[r * 36 + e] = val; }
        __syncthreads();
        const int r = tid >> 6, k = tid & 63;
        { float a = b1[k];
#pragma unroll
          for (int e = 0; e < 33; ++e) a += zf[r * 36 + e] * w1[e * 64 + k];
          h1[r * 64 + k] = __sinf(f1[k] * a); }
        __syncthreads();
        { float a = b2[k];
#pragma unroll 16
          for (int m = 0; m < 64; ++m) a += h1[r * 64 + m] * w2[m * 64 + k];
          HID2[(size_t)(row0 + r) * 64 + k] = __sinf(f2[k] * a); }
        __syncthreads();
    }
}

#define TSW(col, r) ((col) * 72 + (((((r) >> 3) ^ (((col) >> 4) & 7)) << 3) | ((r) & 7)))
#ifndef PREP_SKIP
#define PREP_SKIP 0
#endif
__device__ __forceinline__ void phase_prep(const Params& p, int l, unsigned char* shm, int it_lo = 0, int it_hi = 3072, bool dmy = false) {
    const int j = l >> 1;
    bf16_t* qs = (bf16_t*)shm;
    bf16_t* ks = qs + 64 * 136;
    bf16_t* vT = ks + 64 * 136;
    bf16_t* kT = vT + 128 * 72;
    bf16_t* kdTs = kT + 128 * 72;
    bf16_t* Ts = kdTs + 128 * 72;
    float* Lm = (float*)(Ts + 64 * 72);
    float* gs = Lm + 64 * 68; float* gcs = gs + 64; float* bts = gcs + 64; float* Xs = bts + 64;
    const bf16_t* QKV = (const bf16_t*)(p.ws + B_QKV); const float* SIDE = (const float*)(p.ws + OFF_SIDE); float* GL = (float*)(p.ws + OFF_GL);
    const float* cw = p.in[I_ABCONV] + j * 3 * 1536;
    for (int it = it_lo + lbid(); it < it_hi; it += (int)gridDim.x) {
        const int tid = ltid(), lane = tid & 63, wid = tid >> 6, fr = lane & 15, fq = lane >> 4;
        const int ty = it / 1536, r1 = it % 1536, d = r1 / 768, r2 = r1 % 768, h = r2 / 192, cgi = r2 % 192;
        const int tok0 = cgi * 64; int sbase, L; tokinfo(tok0, sbase, L);
        bf16_t* item = ty == 0 ? (bf16_t*)(p.ws + B_PREPD + (size_t)((d * 4 + h) * 192 + cgi) * ITEM_D) : (bf16_t*)(p.ws + B_PREPR + (size_t)((d * 4 + h) * 192 + cgi) * ITEM_R);
        if (dmy) item = (bf16_t*)(p.ws + 344 * MB + (size_t)(it & 255) * ITEM_D);
        const int r_ = tid >> 3, jj = tid & 7;
        const int t = d ? tok0 + 63 - r_ : tok0 + r_;
        uint4 vp0, vp1;
        vp0 = make_uint4(0, 0, 0, 0); vp1 = vp0;
        if (ty == 0 && !(dmy && (PREP_SKIP & 2))) {
#pragma unroll
            for (int part = 0; part < 3; ++part) {
                const int col = part * 512 + h * 128 + jj * 16;
                float a[16];
#pragma unroll
                for (int e = 0; e < 16; ++e) a[e] = 0.f;
                uint4 ld0[3], ld1[3];
#pragma unroll
                for (int i = 0; i < 3; ++i) { const int tt = t + i - 1; const bool ok = tt >= sbase && tt < sbase + L; const uint4* px = (const uint4*)(QKV + (size_t)(ok ? tt : t) * 3072 + col);
                    ld0[i] = px[0]; ld1[i] = px[1]; if (!ok) { ld0[i] = make_uint4(0, 0, 0, 0); ld1[i] = ld0[i]; } }
#pragma unroll
                for (int i = 0; i < 3; ++i) { float x[16]; unpack8(ld0[i], x); unpack8(ld1[i], x + 8);
                    const float4* cwp = (const float4*)(cw + i * 1536 + col);
#pragma unroll
                    for (int e4 = 0; e4 < 4; ++e4) { const float4 wv = cwp[e4]; a[e4 * 4] += x[e4 * 4] * wv.x; a[e4 * 4 + 1] += x[e4 * 4 + 1] * wv.y; a[e4 * 4 + 2] += x[e4 * 4 + 2] * wv.z; a[e4 * 4 + 3] += x[e4 * 4 + 3] * wv.w; } }
                float ssq = 0.f;
#pragma unroll
                for (int e = 0; e < 16; ++e) { a[e] = silu(a[e]); ssq += a[e] * a[e]; }
                if (part < 2) {
                    ssq += shx(ssq, 1, lane); ssq += shx(ssq, 2, lane); ssq += shx(ssq, 4, lane);
                    const float rn = rsqrtf(ssq + 1e-6f) * (part == 0 ? 0.08838834764831845f : 1.0f);
#pragma unroll
                    for (int e = 0; e < 16; ++e) a[e] *= rn;
                    bf16_t* dq = (part == 0 ? qs : ks) + r_ * 136 + jj * 16;
                    *(uint4*)dq = pack8(a); *(uint4*)(dq + 8) = pack8(a + 8);
                } else { vp0 = pack8(a); vp1 = pack8(a + 8); }
            }
        } else {
            const bf16_t* src = QKV + (size_t)t * 3072 + 1536 + h * 128 + jj * 16;
            { float a[16]; const uint4* px = (const uint4*)src; unpack8(px[0], a); unpack8(px[1], a + 8);
#pragma unroll
              for (int e = 0; e < 16; ++e) a[e] *= 0.08838834764831845f;
              *(uint4*)(qs + r_ * 136 + jj * 16) = pack8(a); *(uint4*)(qs + r_ * 136 + jj * 16 + 8) = pack8(a + 8); }
            { const uint4* px = (const uint4*)(src + 512); *(uint4*)(ks + r_ * 136 + jj * 16) = px[0]; *(uint4*)(ks + r_ * 136 + jj * 16 + 8) = px[1]; }
            { const uint4* px = (const uint4*)(src + 1024); vp0 = px[0]; vp1 = px[1]; }
        }
        if (dmy && (PREP_SKIP & 64)) continue;
        if (jj == 0) {
            float g, beta;
            if (ty == 0) { const float a_raw = SIDE[(size_t)t * 16 + d * 4 + h], b_raw = SIDE[(size_t)t * 16 + 8 + d * 4 + h];
                const float A = expf(p.in[I_ALOG][j * 8 + d * 4 + h]); const float x = a_raw + p.in[I_DTB][j * 8 + d * 4 + h];
                const float sp = x > 20.f ? x : log1pf(expf(x)); g = -A * sp; beta = 1.0f / (1.0f + expf(-b_raw)); }
            else { g = -expf(p.in[I_RDEC][j * 8 + d * 4 + h]); beta = 1.f; }
            gs[r_] = g; bts[r_] = beta; }
        __syncthreads();
        if (tid < 64) { float a = gs[tid];
#pragma unroll
            for (int o = 1; o < 64; o <<= 1) { const float tt = __int_as_float(__builtin_amdgcn_ds_bpermute(((lane - o) & 63) << 2, __float_as_int(a))); if (tid >= o) a += tt; }
            gcs[tid] = a; }
        __syncthreads();
        if (!(dmy && (PREP_SKIP & 8))) {   const float gr = gcs[r_], glast = gcs[63], eg = __expf(gr), ek = __expf(glast - gr), b = bts[r_];
            {   float q[16]; unpack8(*(const uint4*)(qs + r_ * 136 + jj * 16), q); unpack8(*(const uint4*)(qs + r_ * 136 + jj * 16 + 8), q + 8);
#pragma unroll
                for (int e = 0; e < 16; ++e) q[e] *= eg;
                *(uint4*)(item + PO_QD + r_ * 128 + jj * 16) = pack8(q); *(uint4*)(item + PO_QD + r_ * 128 + jj * 16 + 8) = pack8(q + 8); }
            if (ty == 1) { *(uint4*)(item + PO_U + r_ * 128 + jj * 16) = vp0; *(uint4*)(item + PO_U + r_ * 128 + jj * 16 + 8) = vp1; }
            {   float k[16]; unpack8(*(const uint4*)(ks + r_ * 136 + jj * 16), k); unpack8(*(const uint4*)(ks + r_ * 136 + jj * 16 + 8), k + 8);
#pragma unroll
                for (int e = 0; e < 16; ++e) { const int col = jj * 16 + e; kdTs[TSW(col, r_)] = f2bf(k[e] * ek); if (ty == 0) kT[TSW(col, r_)] = f2bf(k[e] * b * eg); } }
            if (ty == 0) { float v[16]; unpack8(vp0, v); unpack8(vp1, v + 8);
#pragma unroll
                for (int e = 0; e < 16; ++e) vT[TSW(jj * 16 + e, r_)] = f2bf(v[e] * b); }
            if (tid == 0 && !dmy) GL[((ty * 2 + d) * 4 + h) * 192 + cgi] = __expf(glast);
        }
        __syncthreads();
        {
#pragma unroll
            for (int q2 = 0; q2 < ((dmy && (PREP_SKIP & 16)) ? 0 : 2); ++q2) {
                const int tix = wid * 2 + q2, tm = tix >> 2, tn = tix & 3;
                f32x4 aQ = {0.f, 0.f, 0.f, 0.f}, aK = {0.f, 0.f, 0.f, 0.f};
#pragma unroll
                for (int k0 = 0; k0 < 128; k0 += 32) {
                    const bf16x8 fs = *(const bf16x8*)(ks + (tn * 16 + fr) * 136 + k0 + fq * 8);
                    const bf16x8 fc = *(const bf16x8*)(qs + (tm * 16 + fr) * 136 + k0 + fq * 8);
                    aQ = __builtin_amdgcn_mfma_f32_16x16x32_bf16(fs, fc, aQ, 0, 0, 0);
                    if (ty == 0) { const bf16x8 fk = *(const bf16x8*)(ks + (tm * 16 + fr) * 136 + k0 + fq * 8); aK = __builtin_amdgcn_mfma_f32_16x16x32_bf16(fs, fk, aK, 0, 0, 0); }
                }
                const int c = tm * 16 + fr, s0 = tn * 16 + fq * 4; const float gcc = gcs[c], bc = bts[c];
                float av[4], lv[4];
#pragma unroll
                for (int jx = 0; jx < 4; ++jx) { const int sx = s0 + jx; const float dec = (sx <= c) ? __expf(gcc - gcs[sx]) : 0.f; av[jx] = aQ[jx] * dec; lv[jx] = (sx < c) ? bc * aK[jx] * dec : 0.f; }
                uint2 pk; pk.x = cvt_pk_bf16(av[0], av[1]); pk.y = cvt_pk_bf16(av[2], av[3]);
                *(uint2*)(item + PO_ATT + c * 64 + s0) = pk;
                if (ty == 0) *(float4*)(Lm + c * 68 + s0) = make_float4(lv[0], lv[1], lv[2], lv[3]);
            }
        }
        __syncthreads();
        if (ty == 0) {
            for (int I = 0; I < ((dmy && (PREP_SKIP & 1)) ? 0 : 4); ++I) {
                {   const int jc = tid & 63, rr = tid >> 6, r0 = 16 * I + rr, r1 = r0 + 8;
                    float a0 = (r0 == jc) ? 1.f : 0.f, a1 = (r1 == jc) ? 1.f : 0.f;
#pragma unroll 4
                    for (int s = 0; s < 16 * I; s += 4) {
                        const float4 l0 = *(const float4*)(Lm + r0 * 68 + s), l1 = *(const float4*)(Lm + r1 * 68 + s);
                        const float x0 = Xs[s * 65 + jc], x1 = Xs[(s + 1) * 65 + jc], x2 = Xs[(s + 2) * 65 + jc], x3 = Xs[(s + 3) * 65 + jc];
                        a0 -= l0.x * x0; a0 -= l0.y * x1; a0 -= l0.z * x2; a0 -= l0.w * x3;
                        a1 -= l1.x * x0; a1 -= l1.y * x1; a1 -= l1.z * x2; a1 -= l1.w * x3; }
                    Xs[r0 * 65 + jc] = a0; Xs[r1 * 65 + jc] = a1; }
                __syncthreads();
                if (wid == 0) {
                    float x[16];
                    const float* Lb = Lm + (16 * I) * 68 + 16 * I;
#pragma unroll
                    for (int r = 0; r < 16; ++r) {
                        float a = Xs[(16 * I + r) * 65 + lane];
#pragma unroll
                        for (int s4 = 0; s4 < (r + 3) / 4; ++s4) { const float4 lv = *(const float4*)(Lb + r * 68 + s4 * 4);
                            if (s4 * 4 + 0 < r) a -= lv.x * x[s4 * 4 + 0]; if (s4 * 4 + 1 < r) a -= lv.y * x[s4 * 4 + 1]; if (s4 * 4 + 2 < r) a -= lv.z * x[s4 * 4 + 2]; if (s4 * 4 + 3 < r) a -= lv.w * x[s4 * 4 + 3]; }
                        x[r] = a;
                    }
#pragma unroll
                    for (int r = 0; r < 16; ++r) Xs[(16 * I + r) * 65 + lane] = x[r];
                }
                __syncthreads();
            }
#pragma unroll
            for (int i = 0; i < 8; ++i) { const int idx = tid + i * 512; Ts[(idx >> 6) * 72 + (idx & 63)] = f2bf(Xs[(idx >> 6) * 65 + (idx & 63)]); }
            __syncthreads();
#pragma unroll
            for (int q2 = 0; q2 < ((dmy && (PREP_SKIP & 4)) ? 0 : 4); ++q2) {
                const int tix = wid * 4 + q2, tm = tix >> 3, tn = tix & 7;
                f32x4 aU = {0.f, 0.f, 0.f, 0.f}, aW = {0.f, 0.f, 0.f, 0.f};
#pragma unroll
                for (int k0 = 0; k0 < 64; k0 += 32) {
                    const bf16x8 fc = *(const bf16x8*)(Ts + (tm * 16 + fr) * 72 + k0 + fq * 8);
                    const bf16x8 fu = *(const bf16x8*)(vT + TSW(tn * 16 + fr, k0 + fq * 8));
                    const bf16x8 fw = *(const bf16x8*)(kT + TSW(tn * 16 + fr, k0 + fq * 8));
                    aU = __builtin_amdgcn_mfma_f32_16x16x32_bf16(fu, fc, aU, 0, 0, 0);
                    aW = __builtin_amdgcn_mfma_f32_16x16x32_bf16(fw, fc, aW, 0, 0, 0);
                }
                const int c = tm * 16 + fr, col0 = tn * 16 + fq * 4;
                uint2 pu; pu.x = cvt_pk_bf16(aU[0], aU[1]); pu.y = cvt_pk_bf16(aU[2], aU[3]);
                uint2 pw; pw.x = cvt_pk_bf16(aW[0], aW[1]); pw.y = cvt_pk_bf16(aW[2], aW[3]);
                *(uint2*)(item + PO_U + c * 128 + col0) = pu; *(uint2*)(item + PO_W + c * 128 + col0) = pw;
            }
        }
#pragma unroll
        for (int i = 0; i < ((dmy && (PREP_SKIP & 32)) ? 0 : 2); ++i) { const int idx = tid + i * 512, row = idx >> 3, seg = idx & 7; *(uint4*)(item + PO_KDT + row * 64 + seg * 8) = *(const uint4*)(kdTs + TSW(row, seg * 8)); }
        __syncthreads();
    }
}

#ifndef SCAN_SKIP
#define SCAN_SKIP 0
#endif
__device__ __forceinline__ void scan_item(const Params& p, int l, int item, unsigned char* shm, bool dmy = false) {
    const int tid = ltid(), lane = tid & 63, wid = tid >> 6, fr = lane & 15, fq = lane >> 4, j = l >> 1;
    bf16_t* Ws = (bf16_t*)shm;
    bf16_t* Qs = Ws + 64 * 136;
    bf16_t* As = Qs + 64 * 136;
    bf16_t* Ks = As + 2 * 64 * 72;
    bf16_t* Us = Ks + 2 * 128 * 72;
    bf16_t* STs = Us + 64 * 40;
    bf16_t* VNs = STs + 32 * 136;
    float* GLs = (float*)(VNs + 32 * 72);
    int ty, seq, d, h, sl, chunk0, N, lat;
    if (item < 128) { lat = 1; ty = item >> 6; const int r = item & 63; seq = r >> 5; d = (r >> 4) & 1; h = (r >> 2) & 3; sl = r & 3; chunk0 = 64 + seq * 64; N = 64; }
    else { lat = 0; const int r0 = item - 128; ty = r0 >> 9; const int r = r0 & 511; seq = r >> 5; d = (r >> 4) & 1; h = (r >> 2) & 3; sl = r & 3; chunk0 = seq * 4; N = 4; }
    const int v0 = sl * 32;
    const unsigned char* pbase = ty == 0 ? p.ws + B_PREPD + (size_t)((d * 4 + h) * 192) * ITEM_D : p.ws + B_PREPR + (size_t)((d * 4 + h) * 192) * ITEM_R;
    const size_t istride = ty == 0 ? ITEM_D : ITEM_R;
    const float* GL = (const float*)(p.ws + OFF_GL) + ((ty * 2 + d) * 4 + h) * 192;
    bf16_t* ODIR = (bf16_t*)(p.ws + (dmy ? 336 * MB : B_ODIR));
    f32x4 ST0, ST1;
    if (lat) { const float* s0 = p.in[ty == 0 ? I_SD : I_SR] + (size_t)((((seq * 2 + j) * 2 + d) * 4 + h)) * 16384;
        ST0 = *(const f32x4*)(s0 + (wid * 16 + fr) * 128 + v0 + fq * 4); ST1 = *(const f32x4*)(s0 + (wid * 16 + fr) * 128 + v0 + 16 + fq * 4); }
    else { ST0 = (f32x4){0.f, 0.f, 0.f, 0.f}; ST1 = ST0; }
    struct Pre { uint4 w0, w1, q0, q1, k0, k1, a, u; };
    Pre PA, PB, PC, PD;
    PA.w0 = PA.w1 = PA.u = make_uint4(0, 0, 0, 0); PB = PA; PC = PA; PD = PA;
#define SCAN_LOAD(P, cgx) do { const bf16_t* it_ = (const bf16_t*)(pbase + (size_t)(cgx) * istride); const int i0_ = tid, i1_ = tid + 512; \
        if (ty == 0) { P.w0 = *(const uint4*)(it_ + PO_W + (i0_ >> 4) * 128 + (i0_ & 15) * 8); P.w1 = *(const uint4*)(it_ + PO_W + (i1_ >> 4) * 128 + (i1_ & 15) * 8); } \
        P.q0 = *(const uint4*)(it_ + PO_QD + (i0_ >> 4) * 128 + (i0_ & 15) * 8); P.q1 = *(const uint4*)(it_ + PO_QD + (i1_ >> 4) * 128 + (i1_ & 15) * 8); \
        P.k0 = *(const uint4*)(it_ + PO_KDT + i0_ * 8); P.k1 = *(const uint4*)(it_ + PO_KDT + i1_ * 8); \
        P.a = *(const uint4*)(it_ + PO_ATT + tid * 8); \
        if (tid < 256) P.u = *(const uint4*)(it_ + PO_U + (tid >> 2) * 128 + v0 + (tid & 3) * 8); } while (0)
#define SCAN_STORE(P, par_) do { const int i0_ = tid, i1_ = tid + 512; bf16_t* As_ = As + (par_) * (64 * 72); bf16_t* Ks_ = Ks + (par_) * (128 * 72); \
        if (ty == 0) { *(uint4*)(Ws + (i0_ >> 4) * 136 + (i0_ & 15) * 8) = P.w0; *(uint4*)(Ws + (i1_ >> 4) * 136 + (i1_ & 15) * 8) = P.w1; } \
        *(uint4*)(Qs + (i0_ >> 4) * 136 + (i0_ & 15) * 8) = P.q0; *(uint4*)(Qs + (i1_ >> 4) * 136 + (i1_ & 15) * 8) = P.q1; \
        *(uint4*)(Ks_ + (i0_ >> 3) * 72 + (i0_ & 7) * 8) = P.k0; *(uint4*)(Ks_ + (i1_ >> 3) * 72 + (i1_ & 7) * 8) = P.k1; \
        *(uint4*)(As_ + (tid >> 3) * 72 + (tid & 7) * 8) = P.a; \
        if (tid < 256) *(uint4*)(Us + (tid >> 2) * 40 + (tid & 3) * 8) = P.u; } while (0)
#define SCAN_ST_STORE() do { \
        STs[(fq * 4 + 0) * 136 + wid * 16 + fr] = f2bf(ST0[0]); STs[(fq * 4 + 1) * 136 + wid * 16 + fr] = f2bf(ST0[1]); STs[(fq * 4 + 2) * 136 + wid * 16 + fr] = f2bf(ST0[2]); STs[(fq * 4 + 3) * 136 + wid * 16 + fr] = f2bf(ST0[3]); \
        STs[(16 + fq * 4 + 0) * 136 + wid * 16 + fr] = f2bf(ST1[0]); STs[(16 + fq * 4 + 1) * 136 + wid * 16 + fr] = f2bf(ST1[1]); STs[(16 + fq * 4 + 2) * 136 + wid * 16 + fr] = f2bf(ST1[2]); STs[(16 + fq * 4 + 3) * 136 + wid * 16 + fr] = f2bf(ST1[3]); } while (0)
#define CHUNK_OF(n_) (chunk0 + (d ? N - 1 - (n_) : (n_)))
    const int tc = wid >> 1, tv = wid & 1;
#define SCAN_STEP(n, PNEXT, PLOAD) do { \
        const int cgi = CHUNK_OF(n); \
        if ((n) + 4 < N && !(dmy && (SCAN_SKIP & 1))) SCAN_LOAD(PLOAD, CHUNK_OF((n) + 4)); \
        const float gl = GLs[n]; \
        f32x4 aV = {0.f, 0.f, 0.f, 0.f}, aO = {0.f, 0.f, 0.f, 0.f}; \
        _Pragma("unroll") for (int k0 = 0; k0 < ((dmy && (SCAN_SKIP & 4)) ? 0 : 128); k0 += 32) { \
            const bf16x8 fb = *(const bf16x8*)(STs + (tv * 16 + fr) * 136 + k0 + fq * 8); \
            const bf16x8 fqd = *(const bf16x8*)(Qs + (tc * 16 + fr) * 136 + k0 + fq * 8); \
            aO = __builtin_amdgcn_mfma_f32_16x16x32_bf16(fb, fqd, aO, 0, 0, 0); \
            if (ty == 0) { const bf16x8 fw = *(const bf16x8*)(Ws + (tc * 16 + fr) * 136 + k0 + fq * 8); aV = __builtin_amdgcn_mfma_f32_16x16x32_bf16(fw, fb, aV, 0, 0, 0); } } \
        {   float vn0 = bf2f(Us[(tc * 16 + fq * 4 + 0) * 40 + tv * 16 + fr]) - aV[0], vn1 = bf2f(Us[(tc * 16 + fq * 4 + 1) * 40 + tv * 16 + fr]) - aV[1]; \
            float vn2 = bf2f(Us[(tc * 16 + fq * 4 + 2) * 40 + tv * 16 + fr]) - aV[2], vn3 = bf2f(Us[(tc * 16 + fq * 4 + 3) * 40 + tv * 16 + fr]) - aV[3]; \
            uint2 pk2; pk2.x = cvt_pk_bf16(vn0, vn1); pk2.y = cvt_pk_bf16(vn2, vn3); \
            *(uint2*)(VNs + (tv * 16 + fr) * 72 + tc * 16 + fq * 4) = pk2; } \
        __syncthreads(); \
        _Pragma("unroll") for (int k0 = 0; k0 < 64; k0 += 32) { \
            const bf16x8 fa = *(const bf16x8*)(As + ((n) & 1) * (64 * 72) + (tc * 16 + fr) * 72 + k0 + fq * 8); \
            const bf16x8 fb = *(const bf16x8*)(VNs + (tv * 16 + fr) * 72 + k0 + fq * 8); \
            aO = __builtin_amdgcn_mfma_f32_16x16x32_bf16(fb, fa, aO, 0, 0, 0); } \
        if (!(dmy && (SCAN_SKIP & 8))) {   const int c = tc * 16 + fr; const int tok = d ? cgi * 64 + 63 - c : cgi * 64 + c; uint2 po; po.x = cvt_pk_bf16(aO[0], aO[1]); po.y = cvt_pk_bf16(aO[2], aO[3]); \
            *(uint2*)(ODIR + ((size_t)d * NTOK + tok) * DM + ty * 512 + h * 128 + v0 + tv * 16 + fq * 4) = po; } \
        if (!(dmy && (SCAN_SKIP & 16))) {   f32x4 a = ST0 * gl, b = ST1 * gl; \
            _Pragma("unroll") for (int k0 = 0; k0 < 64; k0 += 32) { \
                const bf16x8 fb = *(const bf16x8*)(Ks + ((n) & 1) * (128 * 72) + (wid * 16 + fr) * 72 + k0 + fq * 8); \
                const bf16x8 fa0 = *(const bf16x8*)(VNs + (fr) * 72 + k0 + fq * 8); \
                const bf16x8 fa1 = *(const bf16x8*)(VNs + (16 + fr) * 72 + k0 + fq * 8); \
                a = __builtin_amdgcn_mfma_f32_16x16x32_bf16(fa0, fb, a, 0, 0, 0); \
                b = __builtin_amdgcn_mfma_f32_16x16x32_bf16(fa1, fb, b, 0, 0, 0); } \
            ST0 = a; ST1 = b; } \
        SCAN_ST_STORE(); \
        if ((n) + 1 < N && !(dmy && (SCAN_SKIP & 2))) SCAN_STORE(PNEXT, ((n) + 1) & 1); \
        __syncthreads(); } while (0)
    if (tid < N) GLs[tid] = GL[CHUNK_OF(tid)];
    SCAN_LOAD(PA, CHUNK_OF(0));
    SCAN_STORE(PA, 0); SCAN_ST_STORE();
    SCAN_LOAD(PB, CHUNK_OF(1)); SCAN_LOAD(PC, CHUNK_OF(2)); SCAN_LOAD(PD, CHUNK_OF(3));
    __syncthreads();
    for (int n = 0; n < N; n += 4) { SCAN_STEP(n, PB, PA); SCAN_STEP(n + 1, PC, PB); SCAN_STEP(n + 2, PD, PC); SCAN_STEP(n + 3, PA, PD); }
    if (!lat && !dmy) { float* o = p.out + (size_t)NTOK * DM + (ty ? 4194304 : 0) + (size_t)((((seq * 2 + j) * 2 + d) * 4 + h)) * 16384;
        *(f32x4*)(o + (wid * 16 + fr) * 128 + v0 + fq * 4) = ST0; *(f32x4*)(o + (wid * 16 + fr) * 128 + v0 + 16 + fq * 4) = ST1; }
#undef SCAN_LOAD
#undef SCAN_STORE
#undef SCAN_ST_STORE
#undef SCAN_STEP
#undef CHUNK_OF
}
__device__ __forceinline__ void phase_scan(const Params& p, int l, unsigned char* shm, bool dmy = false) {
    const int G = (int)gridDim.x, b = lbid();
    if (G == 256) {
        const int x = b & 7, i = b >> 3;
        if (i < 16) scan_item(p, l, (x * 4 + (i >> 2)) * 4 + (i & 3), shm, dmy);
        else { const int i2 = i - 16; for (int r = 0; r < 8; ++r) scan_item(p, l, 128 + (x * 32 + (i2 >> 2) + 4 * r) * 4 + (i2 & 3), shm, dmy); }
    } else for (int it = b; it < 1152; it += G) scan_item(p, l, it, shm);
}

__device__ __forceinline__ void phase_post(const Params& p, int l, unsigned char* shm) {
    const int tid = ltid(), lane = tid & 63, wid = tid >> 6, j = l >> 1;
    const bf16_t* O0 = (const bf16_t*)(p.ws + B_ODIR); const bf16_t* O1 = O0 + (size_t)NTOK * DM; const bf16_t* ZG = (const bf16_t*)(p.ws + B_ZG);
    bf16_t* H = (bf16_t*)(p.ws + OFF_H);
    const int g = lane >> 3, e0 = (lane & 7) * 16;
    const float* nrm = (g < 4 ? p.in[I_NA] : p.in[I_NB]) + j * 128 + e0;
    const int rstride = (int)gridDim.x * 8;
    int row = lbid() * 8 + wid;
    uint4 na0, na1, nb0, nb1, nz0, nz1;
#define PO_LOAD(row_) do { const size_t off_ = (size_t)(row_) * DM + g * 128 + e0; const uint4* pa = (const uint4*)(O0 + off_); na0 = pa[0]; na1 = pa[1]; \
        const uint4* pb = (const uint4*)(O1 + off_); nb0 = pb[0]; nb1 = pb[1]; const uint4* pz = (const uint4*)(ZG + off_); nz0 = pz[0]; nz1 = pz[1]; } while (0)
    if (row < NTOK) PO_LOAD(row);
    for (; row < NTOK; row += rstride) {
        const size_t off = (size_t)row * DM + g * 128 + e0;
        float a[16], b[16], z[16];
        unpack8(na0, a); unpack8(na1, a + 8); unpack8(nb0, b); unpack8(nb1, b + 8); unpack8(nz0, z); unpack8(nz1, z + 8);
        if (row + rstride < NTOK) PO_LOAD(row + rstride);
        float s = 0.f;
#pragma unroll
        for (int e = 0; e < 16; ++e) { a[e] += b[e]; s += a[e]; }
        float mu = 0.f;
        if (g >= 4) { s += shx(s, 1, lane); s += shx(s, 2, lane); s += shx(s, 4, lane); mu = s * (1.0f / 128.0f); }
        float q = 0.f;
#pragma unroll
        for (int e = 0; e < 16; ++e) { a[e] -= mu; q += a[e] * a[e]; }
        q += shx(q, 1, lane); q += shx(q, 2, lane); q += shx(q, 4, lane);
        const float r = rsqrtf(q * (1.0f / 128.0f) + 1e-6f);
#pragma unroll
        for (int e = 0; e < 16; ++e) a[e] = a[e] * r * nrm[e] * silu(z[e]);
        *(uint4*)(H + off) = pack8(a); *(uint4*)(H + off + 8) = pack8(a + 8);
    }
#undef PO_LOAD
}

__device__ __forceinline__ void hyena_kern(const Params& p, int l, unsigned char* shm, int vb, int G) {
    const int j = l >> 1;
    const float* HID2 = (const float*)(p.ws + OFF_HID2);
    const float* w3 = p.in[I_FW3] + (size_t)j * 64 * 2048; const float* fbias = p.in[I_FBIAS] + j * 1024;
    float* hs = (float*)shm;
    float* w3s = hs + 128 * 65;
    for (int it = vb; it < 544; it += G) {
        const int tid = ltid();
        const int big = it < 512; const int L = big ? 4096 : 256; const int r = big ? it : it - 512; const int pt = r >> 4, ct = r & 15;
        const int i0 = pt * 128, c0 = ct * 64; const float* hsrc = HID2 + (size_t)((big ? 0 : 4096) + i0) * 64;
        float* kern = (float*)(p.ws + (big ? B_KERN : B_KERN256));
#pragma unroll
        for (int i = 0; i < 16; ++i) { const int idx = tid + i * 512; hs[(idx >> 6) * 65 + (idx & 63)] = hsrc[idx]; }
#pragma unroll
        for (int i = 0; i < 16; ++i) { const int idx = tid + i * 512; const int k = idx >> 7, cc = idx & 127; w3s[idx] = w3[(size_t)k * 2048 + (cc < 64 ? c0 + cc : 1024 + c0 + cc - 64)]; }
        __syncthreads();
        const int pp = tid & 63, cgp = tid >> 6;
        float af[2][8], ab[2][8];
#pragma unroll
        for (int q = 0; q < 2; ++q)
#pragma unroll
            for (int e = 0; e < 8; ++e) { af[q][e] = 0.f; ab[q][e] = 0.f; }
#pragma unroll 4
        for (int k = 0; k < 64; ++k) { const float h0 = hs[pp * 65 + k], h1 = hs[(pp + 64) * 65 + k];
            const float4 f0 = *(const float4*)(w3s + k * 128 + cgp * 8), f1 = *(const float4*)(w3s + k * 128 + cgp * 8 + 4), g0 = *(const float4*)(w3s + k * 128 + 64 + cgp * 8), g1 = *(const float4*)(w3s + k * 128 + 64 + cgp * 8 + 4);
            const float wf[8] = {f0.x, f0.y, f0.z, f0.w, f1.x, f1.y, f1.z, f1.w}, wb[8] = {g0.x, g0.y, g0.z, g0.w, g1.x, g1.y, g1.z, g1.w};
#pragma unroll
            for (int e = 0; e < 8; ++e) { af[0][e] += h0 * wf[e]; ab[0][e] += h0 * wb[e]; af[1][e] += h1 * wf[e]; ab[1][e] += h1 * wb[e]; } }
#pragma unroll
        for (int q = 0; q < 2; ++q) {
            const int i = i0 + pp + q * 64; const float tt = (float)i / (float)(L - 1);
#pragma unroll
            for (int e = 0; e < 8; ++e) { const int c = c0 + cgp * 8 + e;
                const float dl = fabsf(-3.0701134573253943f + (float)c * ((-15.350567286626972f + 3.0701134573253943f) / 1023.0f));
                const float win = __expf(-tt * dl);
                float* kc = kern + (size_t)c * (2 * L);
                kc[i] = af[q][e] * win + (i == 0 ? fbias[c] : 0.f);
                if (i == 0) kc[L] = 0.f; else kc[2 * L - i] = ab[q][e] * win; }
        }
        __syncthreads();
    }
}
__device__ __forceinline__ void phase_hyena_pre(const Params& p, int l, unsigned char* shm) {
    const int tid = ltid(), j = l >> 1, G = (int)gridDim.x;
    {   float* tile = (float*)shm;
        const bf16_t* U = (const bf16_t*)(p.ws + B_U); float* VXT = (float*)(p.ws + B_VXT);
        const float* cw = p.in[I_HYCW] + (size_t)j * 3 * 3072; const float* cb = p.in[I_HYCB] + j * 3072;
        const int ch = tid & 63, tg = tid >> 6;
        bf16_t xr[2][10];
#define HP_LOAD(it_) do { const int it2 = (it_); const int tt0_ = (it2 >> 4) * 64, c_ = (it2 & 15) * 64 + ch; int sb_, L_; tokinfo(tt0_, sb_, L_); \
            _Pragma("unroll") for (int part = 1; part < 3; ++part) _Pragma("unroll") for (int e = 0; e < 10; ++e) { const int t = tt0_ + tg * 8 + e - 1; const bool ok = t >= sb_ && t < sb_ + L_; \
                const bf16_t xv = U[(size_t)(ok ? t : tt0_) * 3072 + part * 1024 + c_]; xr[part - 1][e] = ok ? xv : (bf16_t)0; } } while (0)
        if (lbid() < 3072) HP_LOAD(lbid());
        for (int it = lbid(); it < 3072; it += G) {
            const int tt0 = (it >> 4) * 64, c0 = (it & 15) * 64; int sbase, L; tokinfo(tt0, sbase, L);
            const int c = c0 + ch;
            float res[8];
#pragma unroll
            for (int e = 0; e < 8; ++e) res[e] = 1.f;
            float xc[2][10];
#pragma unroll
            for (int q = 0; q < 2; ++q)
#pragma unroll
                for (int e = 0; e < 10; ++e) xc[q][e] = bf2f(xr[q][e]);
            if (it + G < 3072) HP_LOAD(it + G);
#pragma unroll
            for (int part = 1; part < 3; ++part) { const int col = part * 1024 + c;
                const float w0 = cw[col], w1 = cw[3072 + col], w2 = cw[6144 + col], bb = cb[col];
#pragma unroll
                for (int e = 0; e < 8; ++e) res[e] *= (xc[part - 1][e] * w0 + xc[part - 1][e + 1] * w1 + xc[part - 1][e + 2] * w2 + bb); }
#pragma unroll
            for (int e = 0; e < 8; ++e) tile[ch * 65 + tg * 8 + e] = res[e];
            __syncthreads();
            {   const int r = tid >> 3, e0 = (tid & 7) * 8;
                float* dst = VXT + (size_t)sbase * DM + (size_t)(c0 + r) * L + (tt0 - sbase) + e0;
                float4 o0, o1; o0.x = tile[r * 65 + e0]; o0.y = tile[r * 65 + e0 + 1]; o0.z = tile[r * 65 + e0 + 2]; o0.w = tile[r * 65 + e0 + 3];
                o1.x = tile[r * 65 + e0 + 4]; o1.y = tile[r * 65 + e0 + 5]; o1.z = tile[r * 65 + e0 + 6]; o1.w = tile[r * 65 + e0 + 7];
                *(float4*)dst = o0; *(float4*)(dst + 4) = o1; }
            __syncthreads();
        }
#undef HP_LOAD
    }
}

#define PI(i) ((i) + ((i) >> 4))
template <bool INV> __device__ __forceinline__ float2 cmulw(float2 v, float c, float s) {
    return INV ? make_float2(v.x * c - v.y * s, v.x * s + v.y * c) : make_float2(v.x * c + v.y * s, v.y * c - v.x * s);
}
template <bool INV> __device__ __forceinline__ void bfly8(float2 (&x)[8], float fr) {
    const float hh = 0.70710678118654752f;
    const float c1 = __builtin_amdgcn_cosf(fr), s1 = __builtin_amdgcn_sinf(fr);
    const float c2 = c1 * c1 - s1 * s1, s2 = 2.f * c1 * s1, c4 = c2 * c2 - s2 * s2, s4 = 2.f * c2 * s2;
    const float tc[4] = {c1, (c1 - s1) * hh, -s1, -(c1 + s1) * hh}, ts[4] = {s1, (c1 + s1) * hh, c1, (c1 - s1) * hh};
    const float mc[2] = {c2, -s2}, ms[2] = {s2, c2};
    if (!INV) {
#pragma unroll
        for (int k = 0; k < 4; ++k) { const float2 a = x[k], b = x[k + 4]; x[k] = make_float2(a.x + b.x, a.y + b.y); x[k + 4] = cmulw<false>(make_float2(a.x - b.x, a.y - b.y), tc[k], ts[k]); }
#pragma unroll
        for (int q = 0; q < 4; ++q) { const int k = (q & 1) + (q >> 1) * 4; const float2 a = x[k], b = x[k + 2]; x[k] = make_float2(a.x + b.x, a.y + b.y); x[k + 2] = cmulw<false>(make_float2(a.x - b.x, a.y - b.y), mc[k & 1], ms[k & 1]); }
#pragma unroll
        for (int k = 0; k < 8; k += 2) { const float2 a = x[k], b = x[k + 1]; x[k] = make_float2(a.x + b.x, a.y + b.y); x[k + 1] = cmulw<false>(make_float2(a.x - b.x, a.y - b.y), c4, s4); }
    } else {
#pragma unroll
        for (int k = 0; k < 8; k += 2) { const float2 a = x[k], t = cmulw<true>(x[k + 1], c4, s4); x[k] = make_float2(a.x + t.x, a.y + t.y); x[k + 1] = make_float2(a.x - t.x, a.y - t.y); }
#pragma unroll
        for (int q = 0; q < 4; ++q) { const int k = (q & 1) + (q >> 1) * 4; const float2 a = x[k], t = cmulw<true>(x[k + 2], mc[k & 1], ms[k & 1]); x[k] = make_float2(a.x + t.x, a.y + t.y); x[k + 2] = make_float2(a.x - t.x, a.y - t.y); }
#pragma unroll
        for (int k = 0; k < 4; ++k) { const float2 a = x[k], t = cmulw<true>(x[k + 4], tc[k], ts[k]); x[k] = make_float2(a.x + t.x, a.y + t.y); x[k + 4] = make_float2(a.x - t.x, a.y - t.y); }
    }
}
template <bool INV> __device__ __forceinline__ void fft_pass8(float2* X, int s_top, int ngroups) {
    const int sh = s_top - 2, m3 = 1 << sh; const float i8 = 1.0f / (float)(8 * m3);
    const float hh = 0.70710678118654752f;
    for (int g = ltid(); g < ngroups; g += 512) {
        const int lo = g & (m3 - 1), hi = g >> sh, base = (hi << (s_top + 1)) | lo;
        float2 x[8];
#pragma unroll
        for (int k = 0; k < 8; ++k) x[k] = X[PI(base + k * m3)];
        const float fr = (float)lo * i8; const float c1 = __builtin_amdgcn_cosf(fr), s1 = __builtin_amdgcn_sinf(fr);
        const float c2 = c1 * c1 - s1 * s1, s2 = 2.f * c1 * s1, c4 = c2 * c2 - s2 * s2, s4 = 2.f * c2 * s2;
        const float tc[4] = {c1, (c1 - s1) * hh, -s1, -(c1 + s1) * hh}, ts[4] = {s1, (c1 + s1) * hh, c1, (c1 - s1) * hh};
        const float mc[2] = {c2, -s2}, ms[2] = {s2, c2};
        if (!INV) {
#pragma unroll
            for (int k = 0; k < 4; ++k) { const float2 a = x[k], b = x[k + 4]; x[k] = make_float2(a.x + b.x, a.y + b.y); x[k + 4] = cmulw<false>(make_float2(a.x - b.x, a.y - b.y), tc[k], ts[k]); }
#pragma unroll
            for (int q = 0; q < 4; ++q) { const int k = (q & 1) + (q >> 1) * 4; const float2 a = x[k], b = x[k + 2]; x[k] = make_float2(a.x + b.x, a.y + b.y); x[k + 2] = cmulw<false>(make_float2(a.x - b.x, a.y - b.y), mc[k & 1], ms[k & 1]); }
#pragma unroll
            for (int k = 0; k < 8; k += 2) { const float2 a = x[k], b = x[k + 1]; x[k] = make_float2(a.x + b.x, a.y + b.y); x[k + 1] = cmulw<false>(make_float2(a.x - b.x, a.y - b.y), c4, s4); }
        } else {
#pragma unroll
            for (int k = 0; k < 8; k += 2) { const float2 a = x[k], t = cmulw<true>(x[k + 1], c4, s4); x[k] = make_float2(a.x + t.x, a.y + t.y); x[k + 1] = make_float2(a.x - t.x, a.y - t.y); }
#pragma unroll
            for (int q = 0; q < 4; ++q) { const int k = (q & 1) + (q >> 1) * 4; const float2 a = x[k], t = cmulw<true>(x[k + 2], mc[k & 1], ms[k & 1]); x[k] = make_float2(a.x + t.x, a.y + t.y); x[k + 2] = make_float2(a.x - t.x, a.y - t.y); }
#pragma unroll
            for (int k = 0; k < 4; ++k) { const float2 a = x[k], t = cmulw<true>(x[k + 4], tc[k], ts[k]); x[k] = make_float2(a.x + t.x, a.y + t.y); x[k + 4] = make_float2(a.x - t.x, a.y - t.y); }
        }
#pragma unroll
        for (int k = 0; k < 8; ++k) X[PI(base + k * m3)] = x[k];
    }
    __syncthreads();
}
__device__ __forceinline__ void fft_pass2(float2* X, int npairs) {
    for (int g = ltid(); g < npairs; g += 512) { const int q = PI(2 * g); const float2 a = X[q], b = X[q + 1]; X[q] = make_float2(a.x + b.x, a.y + b.y); X[q + 1] = make_float2(a.x - b.x, a.y - b.y); }
    __syncthreads();
}
__device__ __forceinline__ void fft_fwd(float2* X, int lgN, int nelem, bool do_p2 = true) {
    int s = lgN - 1;
    for (; s >= 2; s -= 3) fft_pass8<false>(X, s, nelem >> 3);
    if (s == 0 && do_p2) fft_pass2(X, nelem >> 1);
}
__device__ __forceinline__ void fft_inv(float2* X, int lgN, int goff, int nelem, bool do_p2 = true, int s_last = 1000) {
    int s;
    if ((lgN - 1) % 3 == 0 && !do_p2) s = 3;
    else if ((lgN - 1) % 3 == 0) { for (int g = ltid(); g < (nelem >> 1); g += 512) { const int q = PI(8 * goff + 2 * g); const float2 a = X[q], b = X[q + 1]; X[q] = make_float2(a.x + b.x, a.y + b.y); X[q + 1] = make_float2(a.x - b.x, a.y - b.y); } __syncthreads(); s = 3; } else s = 2;
    for (; s <= lgN - 1 && s <= s_last; s += 3) {
        const int sh = s - 2, m3 = 1 << sh; const float i8 = 1.0f / (float)(8 * m3); const float hh = 0.70710678118654752f;
        for (int g0 = ltid(); g0 < (nelem >> 3); g0 += 512) {
            const int g = g0 + goff; const int lo = g & (m3 - 1), hi = g >> sh, base = (hi << (s + 1)) | lo;
            float2 x[8];
#pragma unroll
            for (int k = 0; k < 8; ++k) x[k] = X[PI(base + k * m3)];
            const float fr = (float)lo * i8; const float c1 = __builtin_amdgcn_cosf(fr), s1 = __builtin_amdgcn_sinf(fr);
            const float c2 = c1 * c1 - s1 * s1, s2 = 2.f * c1 * s1, c4 = c2 * c2 - s2 * s2, s4 = 2.f * c2 * s2;
            const float tc[4] = {c1, (c1 - s1) * hh, -s1, -(c1 + s1) * hh}, ts[4] = {s1, (c1 + s1) * hh, c1, (c1 - s1) * hh};
            const float mc[2] = {c2, -s2}, ms[2] = {s2, c2};
#pragma unroll
            for (int k = 0; k < 8; k += 2) { const float2 a = x[k], t = cmulw<true>(x[k + 1], c4, s4); x[k] = make_float2(a.x + t.x, a.y + t.y); x[k + 1] = make_float2(a.x - t.x, a.y - t.y); }
#pragma unroll
            for (int q = 0; q < 4; ++q) { const int k = (q & 1) + (q >> 1) * 4; const float2 a = x[k], t = cmulw<true>(x[k + 2], mc[k & 1], ms[k & 1]); x[k] = make_float2(a.x + t.x, a.y + t.y); x[k + 2] = make_float2(a.x - t.x, a.y - t.y); }
#pragma unroll
            for (int k = 0; k < 4; ++k) { const float2 a = x[k], t = cmulw<true>(x[k + 4], tc[k], ts[k]); x[k] = make_float2(a.x + t.x, a.y + t.y); x[k + 4] = make_float2(a.x - t.x, a.y - t.y); }
#pragma unroll
            for (int k = 0; k < 8; ++k) X[PI(base + k * m3)] = x[k];
        }
        __syncthreads();
    }
}
__device__ __forceinline__ void phase_hyena_fft(const Params& p, int l, unsigned char* shm) {
    const int G = (int)gridDim.x;
    float2* X = (float2*)shm;
    float* VXT = (float*)(p.ws + B_VXT);
    for (int it = lbid(); it < 2048; it += G) {
        const int tid = ltid();
        if (it < 1024) {
            const int c = it; const float* kern = (const float*)(p.ws + B_KERN) + (size_t)c * 8192;
            float* y0 = VXT + (size_t)NCTX * DM + (size_t)c * 4096; float* y1 = y0 + (size_t)4096 * DM;
#pragma unroll
            for (int q = 0; q < 4; ++q) {
                const int g = tid + q * 512, lo = g & 1023, hi = g >> 10;
                float2 x[8];
                if (hi == 0) {
#pragma unroll
                    for (int k = 0; k < 8; ++k) x[k] = make_float2(kern[lo + 1024 * k], 0.f);
                } else {
#pragma unroll
                    for (int k = 0; k < 4; ++k) x[k] = make_float2(y0[lo + 1024 * k], y1[lo + 1024 * k]);
#pragma unroll
                    for (int k = 4; k < 8; ++k) x[k] = make_float2(0.f, 0.f);
                }
                bfly8<false>(x, (float)lo * (1.0f / 8192.0f));
#pragma unroll
                for (int k = 0; k < 8; ++k) X[PI((hi << 13) + lo + 1024 * k)] = x[k];
            }
            __syncthreads();
            fft_pass8<false>(X, 9, 2048); fft_pass8<false>(X, 6, 2048); fft_pass8<false>(X, 3, 2048);
            for (int g = tid; g < 4096; g += 512) { const int qa = PI(2 * g), qb = PI(8192 + 2 * g);
                const float2 a0 = X[qa], a1 = X[qa + 1], b0 = X[qb], b1 = X[qb + 1];
                const float2 as = make_float2(a0.x + a1.x, a0.y + a1.y), ad = make_float2(a0.x - a1.x, a0.y - a1.y), bs = make_float2(b0.x + b1.x, b0.y + b1.y), bd = make_float2(b0.x - b1.x, b0.y - b1.y);
                const float2 p0 = make_float2(as.x * bs.x - as.y * bs.y, as.x * bs.y + as.y * bs.x), p1 = make_float2(ad.x * bd.x - ad.y * bd.y, ad.x * bd.y + ad.y * bd.x);
                X[qb] = make_float2(p0.x + p1.x, p0.y + p1.y); X[qb + 1] = make_float2(p0.x - p1.x, p0.y - p1.y); }
            __syncthreads();
            fft_inv(X, 13, 1024, 8192, false, 9);
#pragma unroll
            for (int q = 0; q < 2; ++q) {
                const int lo = tid + q * 512;
                float2 x[8];
#pragma unroll
                for (int k = 0; k < 8; ++k) x[k] = X[PI(8192 + lo + 1024 * k)];
                bfly8<true>(x, (float)lo * (1.0f / 8192.0f));
#pragma unroll
                for (int k = 0; k < 4; ++k) { y0[lo + 1024 * k] = x[k].x * (1.0f / 8192.0f); y1[lo + 1024 * k] = x[k].y * (1.0f / 8192.0f); }
            }
            __syncthreads();
        } else {
            const int c = it - 1024; const float* kern = (const float*)(p.ws + B_KERN256) + (size_t)c * 512;
            X[PI(tid)] = make_float2(kern[tid], 0.f);
            {   float va[8], vb[8]; const int q = tid & 511;
#pragma unroll
                for (int pr = 0; pr < 8; ++pr) { const float* ya = VXT + (size_t)(2 * pr) * 256 * DM + (size_t)c * 256; const float* yb = ya + (size_t)256 * DM; va[pr] = q < 256 ? ya[q] : 0.f; vb[pr] = q < 256 ? yb[q] : 0.f; }
#pragma unroll
                for (int pr = 0; pr < 8; ++pr) X[PI(512 + pr * 512 + q)] = make_float2(va[pr], vb[pr]); }
            __syncthreads();
            fft_fwd(X, 9, 512 + 4096);
            for (int m = tid; m < 4096; m += 512) { const float2 a = X[PI(m & 511)], b = X[PI(512 + m)]; X[PI(512 + m)] = make_float2(a.x * b.x - a.y * b.y, a.x * b.y + a.y * b.x); }
            __syncthreads();
            fft_inv(X, 9, 64, 4096);
            for (int m = tid; m < 4096; m += 512) { const int pr = m >> 9, q = m & 511;
                if (q < 256) { float* ya = VXT + (size_t)(2 * pr) * 256 * DM + (size_t)c * 256; float* yb = ya + (size_t)256 * DM; const float2 b = X[PI(512 + m)]; ya[q] = b.x * (1.0f / 512.0f); yb[q] = b.y * (1.0f / 512.0f); } }
            __syncthreads();
        }
    }
}
__device__ __forceinline__ void phase_hyena_post(const Params& p, int l, unsigned char* shm) {
    const int tid = ltid(), j = l >> 1, G = (int)gridDim.x;
    float* tile = (float*)shm;
    const bf16_t* U = (const bf16_t*)(p.ws + B_U); const float* VXT = (const float*)(p.ws + B_VXT); bf16_t* H = (bf16_t*)(p.ws + OFF_H);
    const float* cw = p.in[I_HYCW] + (size_t)j * 3 * 3072; const float* cb = p.in[I_HYCB] + j * 3072;
    const int ch = tid & 63, tg = tid >> 6, r = tid >> 3, e0 = (tid & 7) * 8;
    float4 o0, o1; bf16_t xr[10];
#define HQ_LOAD(it_) do { const int it2 = (it_); const int tt0_ = (it2 >> 4) * 64, c0_ = (it2 & 15) * 64; int sb_, L_; tokinfo(tt0_, sb_, L_); \
        const float* src = VXT + (size_t)sb_ * DM + (size_t)(c0_ + r) * L_ + (tt0_ - sb_) + e0; o0 = *(const float4*)src; o1 = *(const float4*)(src + 4); \
        _Pragma("unroll") for (int e = 0; e < 10; ++e) { const int t = tt0_ + tg * 8 + e - 1; const bool ok = t >= sb_ && t < sb_ + L_; const bf16_t xv = U[(size_t)(ok ? t : tt0_) * 3072 + c0_ + ch]; xr[e] = ok ? xv : (bf16_t)0; } } while (0)
    if (lbid() < 3072) HQ_LOAD(lbid());
    for (int it = lbid(); it < 3072; it += G) {
        const int tt0 = (it >> 4) * 64, c0 = (it & 15) * 64;
        tile[r * 65 + e0] = o0.x; tile[r * 65 + e0 + 1] = o0.y; tile[r * 65 + e0 + 2] = o0.z; tile[r * 65 + e0 + 3] = o0.w;
        tile[r * 65 + e0 + 4] = o1.x; tile[r * 65 + e0 + 5] = o1.y; tile[r * 65 + e0 + 6] = o1.z; tile[r * 65 + e0 + 7] = o1.w;
        float x[10];
#pragma unroll
        for (int e = 0; e < 10; ++e) x[e] = bf2f(xr[e]);
        if (it + G < 3072) HQ_LOAD(it + G);
        __syncthreads();
        const int c = c0 + ch;
        const float w0 = cw[c], w1 = cw[3072 + c], w2 = cw[6144 + c], bb = cb[c];
#pragma unroll
        for (int e = 0; e < 8; ++e) { const float x0 = x[e] * w0 + x[e + 1] * w1 + x[e + 2] * w2 + bb;
            H[(size_t)(tt0 + tg * 8 + e) * DM + c] = f2bf(x0 * tile[ch * 65 + tg * 8 + e]); }
        __syncthreads();
    }
#undef HQ_LOAD
}

__device__ __forceinline__ void phase_ffn_act(const Params& p, int l, unsigned char* shm) {
    const bf16_t* GU = (const bf16_t*)(p.ws + B_GU); bf16_t* ACT = (bf16_t*)(p.ws + B_ACT);
    const int G = (int)gridDim.x, b0 = lbid();
    constexpr int BUFB = 4 * 66 * 128 * 2;
    constexpr int NIT = 1408 + 704;
    uint4 pr[8];
#define FA_ISSUE(it_) do { const int it2 = (it_); const int tid = ltid(); \
        if (it2 < 1408) { const int sq = it2 / 704, rg = (it2 % 704) / 22, cc = it2 % 22; const int sb = NCTX + sq * 4096; \
            _Pragma("unroll") for (int i = 0; i < 8; ++i) { const int idx = tid + i * 512, fgc = idx & 15, col = (idx >> 4) & 63, ri = idx >> 10; const int grow = rg * 2 - 1 + ri; const bool ok = grow >= 0 && grow < 64; \
                pr[i] = *(const uint4*)(GU + (size_t)(sb + (ok ? grow : 0) * 64 + col) * 5632 + cc * 128 + fgc * 8); if (!ok) pr[i] = make_uint4(0, 0, 0, 0); } \
        } else { const int r = it2 - 1408, sq = r / 44, hf = (r / 22) & 1, cc = r % 22; const int sb = sq * 256, t0 = sb + hf * 128; \
            _Pragma("unroll") for (int i = 0; i < 5; ++i) { const int idx = tid + i * 512, fgc = idx & 15, prow = idx >> 4; const int tok = t0 - 1 + prow; const bool ok = idx < 2080 && tok >= sb && tok < sb + 256; \
                pr[i] = *(const uint4*)(GU + (size_t)(ok ? tok : sb) * 5632 + cc * 128 + fgc * 8); if (!ok) pr[i] = make_uint4(0, 0, 0, 0); } } } while (0)
#define FA_STORE(it_, buf_) do { const int it2 = (it_); const int tid = ltid(); bf16_t* B_ = (bf16_t*)(shm + (buf_) * BUFB); \
        if (it2 < 1408) { \
            _Pragma("unroll") for (int i = 0; i < 8; ++i) { const int idx = tid + i * 512, fgc = idx & 15, col = (idx >> 4) & 63, ri = idx >> 10; *(uint4*)(B_ + ((ri * 66 + col + 1) * 128 + fgc * 8)) = pr[i]; } \
            if (tid < 128) { const int fgc = tid & 15, hc = (tid >> 4) & 1, ri = tid >> 5; *(uint4*)(B_ + ((ri * 66 + hc * 65) * 128 + fgc * 8)) = make_uint4(0, 0, 0, 0); } \
        } else { \
            _Pragma("unroll") for (int i = 0; i < 5; ++i) { const int idx = tid + i * 512, fgc = idx & 15, prow = idx >> 4; if (idx < 2080) *(uint4*)(B_ + (prow * 128 + fgc * 8)) = pr[i]; } } } while (0)
    int it = b0, cur = 0;
    if (it < NIT) { FA_ISSUE(it); FA_STORE(it, 0); }
    __syncthreads();
    for (; it < NIT; it += G) {
        const int tid = ltid(), fgc = tid & 15;
        const int nxt = it + G;
        const bf16_t* B_ = (const bf16_t*)(shm + cur * BUFB);
        const bool lat = it < 1408;
        int cc, tokbase;
        if (lat) { const int sq = it / 704, rg = (it % 704) / 22; cc = it % 22; tokbase = NCTX + sq * 4096 + rg * 128; }
        else { const int r = it - 1408, sq = r / 44, hf = (r / 22) & 1; cc = r % 22; tokbase = sq * 256 + hf * 128; }
        const int f0 = cc * 128 + fgc * 8;
        const float* cwp = p.in[I_FCONV] + (size_t)l * 9 * 2816 + f0;
        float bias[8];
        { const float4 a = *(const float4*)(p.in[I_FCB] + l * 2816 + f0), bq = *(const float4*)(p.in[I_FCB] + l * 2816 + f0 + 4);
          bias[0] = a.x; bias[1] = a.y; bias[2] = a.z; bias[3] = a.w; bias[4] = bq.x; bias[5] = bq.y; bias[6] = bq.z; bias[7] = bq.w; }
        uint4 upr[4];
#pragma unroll
        for (int i = 0; i < 4; ++i) { const int o = tid + i * 512; const int tok = tokbase + (o >> 4); upr[i] = *(const uint4*)(GU + (size_t)tok * 5632 + 2816 + f0); }
        float4 wq[9][2];
#pragma unroll
        for (int q = 0; q < 9; ++q) { wq[q][0] = *(const float4*)(cwp + q * 2816); wq[q][1] = *(const float4*)(cwp + q * 2816 + 4); }
        if (nxt < NIT) FA_ISSUE(nxt);
        float acc[4][8];
#pragma unroll
        for (int i = 0; i < 4; ++i)
#pragma unroll
            for (int e = 0; e < 8; ++e) acc[i][e] = bias[e];
#pragma unroll
        for (int q = 0; q < 9; ++q) {
            if (!lat && (q < 3 || q > 5)) continue;
            const float4 wa = wq[q][0], wb = wq[q][1];
            const float w[8] = {wa.x, wa.y, wa.z, wa.w, wb.x, wb.y, wb.z, wb.w};
            const int di = q / 3, dj = q % 3;
#pragma unroll
            for (int i = 0; i < 4; ++i) { const int o = tid + i * 512, pos = o >> 4;
                const int li = lat ? (((pos >> 6) + di) * 66 + (pos & 63) + dj) : (pos + dj);
                float x[8]; unpack8(*(const uint4*)(B_ + (li * 128 + fgc * 8)), x);
#pragma unroll
                for (int e = 0; e < 8; ++e) acc[i][e] += x[e] * w[e]; }
        }
#pragma unroll
        for (int i = 0; i < 4; ++i) { const int o = tid + i * 512; const int tok = tokbase + (o >> 4); float up[8]; unpack8(upr[i], up);
#pragma unroll
            for (int e = 0; e < 8; ++e) acc[i][e] = silu(acc[i][e]) * up[e];
            *(uint4*)(ACT + (size_t)tok * 2816 + f0) = pack8(acc[i]); }
        if (nxt < NIT) FA_STORE(nxt, cur ^ 1);
        __syncthreads();
        cur ^= 1;
    }
#undef FA_ISSUE
#undef FA_STORE
}

constexpr int NPHASE = 42;
#ifndef ONLY
#define ONLY -1
#endif
#define ON(id) (ONLY < 0 || ONLY == (id))
__device__ __forceinline__ void run_phase(const Params& p, int ph, unsigned char* shm) {
    int pr_lo = 0, pr_hi = 3072; if (ph >= 3000) { ph -= 3000; pr_lo = 1536; } else if (ph >= 2000) { ph -= 2000; pr_hi = 1536; }
    const bool dummy = ph >= 1000; if (dummy) ph -= 1000;
    float* const XR = dummy ? (float*)(p.ws + OFF_BIG + 200 * MB) : p.out;
    if (ph == 0) { if (ON(0)) phase_prologue(p, shm); return; }
    if (ph == NPHASE - 1) { if (ON(1)) norm_rows(p, 0, 2, shm); return; }
    const int l = (ph - 1) / 10, s = (ph - 1) % 10; const bool even = (l & 1) == 0; const int j = l >> 1;
    const float* MOD = (const float*)(p.ws + OFF_MOD);
    bf16_t* H = (bf16_t*)(p.ws + OFF_H);
    switch (s) {
    case 0: if (ON(2)) norm_rows(p, l, 0, shm); __syncthreads(); if (ON(2)) { if (!even) hyena_hid2(p, l, shm); } break;
    case 1: if (even && ON(3)) { EpiBf16S E; E.O1 = (bf16_t*)(p.ws + B_QKV); E.ld1 = 3072; E.nsplit = 12; E.O2 = (bf16_t*)(p.ws + B_ZG); E.ld2 = 1024; E.bias = nullptr;
                run_gemm(shm, H, (const bf16_t*)(p.ws + OFF_WIN), 4096, 1024, E); }
            else if (!even && ON(4)) { EpiBf16S E; E.O1 = (bf16_t*)(p.ws + B_U); E.ld1 = 3072; E.nsplit = 1000; E.O2 = nullptr; E.ld2 = 0; E.bias = p.in[I_HYBIN] + j * 3072;
                run_gemm(shm, H, (const bf16_t*)(p.ws + OFF_WIN), 3072, 1024, E);
                { const int G = (int)gridDim.x, b = lbid(); if (G > 64) { if (b >= 64) hyena_kern(p, l, shm, b - 64, G - 64); } else hyena_kern(p, l, shm, b, G); } }
            break;
    case 2: if (even) { if (ON(5)) phase_prep(p, l, shm, pr_lo, pr_hi, pr_lo != 0 || pr_hi != 3072); } else if (ON(6)) phase_hyena_pre(p, l, shm); break;
    case 3: if (even) { if (ON(7)) phase_scan(p, l, shm, pr_hi != 3072); } else if (ON(8)) phase_hyena_fft(p, l, shm); break;
    case 4: if (even) { if (ON(9)) phase_post(p, l, shm); } else if (ON(10)) phase_hyena_post(p, l, shm); break;
    case 5: if (ON(11)) { EpiRes E; E.X = XR; E.XinC = (l == 0) ? p.in[I_XP] : XR; E.XinL = (l == 0) ? p.in[I_XS] - (size_t)NCTX * DM : XR; E.gate = MOD + (l * 3) * 6144 + 2048; E.bias = even ? nullptr : p.in[I_HYBOUT] + j * 1024;
              run_gemm(shm, H, (const bf16_t*)(p.ws + OFF_WOUT), 1024, 1024, E);
              if (!dummy) { const int G = (int)gridDim.x, b = lbid(); if (G > 192) { if (b >= 192) convert_ffn(p, l, shm, b - 192, G - 192); } else convert_ffn(p, l, shm, b, G); } } break;
    case 6: if (ON(12)) { norm_rows(p, l, 1, shm); } break;
    case 7: if (ON(13)) { EpiBf16S E; E.O1 = (bf16_t*)(p.ws + B_GU); E.ld1 = 5632; E.nsplit = 1000; E.O2 = nullptr; E.ld2 = 0; E.bias = nullptr;
              run_gemm(shm, H, (const bf16_t*)(p.ws + OFF_WGU), 5632, 1024, E); } break;
    case 8: if (ON(14)) phase_ffn_act(p, l, shm); break;
    case 9: if (ON(15)) { EpiRes E; E.X = XR; E.XinC = XR; E.XinL = XR; E.gate = MOD + (l * 3) * 6144 + 5120; E.bias = nullptr;
              run_gemm(shm, (const bf16_t*)(p.ws + B_ACT), (const bf16_t*)(p.ws + OFF_WDN), 1024, 2816, E);
              if (!dummy && l < 3) { const int G = (int)gridDim.x, b = lbid(); if (G > 192) { if (b >= 192) convert_mixer(p, l + 1, shm, b - 192, G - 192); } else convert_mixer(p, l + 1, shm, b, G); } } break;
    }
}

typedef const __attribute__((address_space(4))) Params* KP;
__global__ void __launch_bounds__(512, 2) mk_fwd(Params p) {
    extern __shared__ __attribute__((aligned(16))) unsigned char shm[];
    cg::grid_group grid = cg::this_grid();
    KP kp0 = (KP)__builtin_amdgcn_kernarg_segment_ptr();
    const int lo = p.lo, hi = p.hi;
    volatile LAS unsigned* st = (volatile LAS unsigned*)(shm + LDS_BYTES - 64);
    if (threadIdx.x < 2) st[threadIdx.x] = 0u;
    __syncthreads();
    XcdBarrier xb = xcd_barrier_post((unsigned*)(p.ws + OFF_BAR), st);
    for (int ph = lo; ph < hi; ++ph) {
        KP kp = kp0; asm volatile("" : "+s"(kp));
        run_phase(*(const Params*)kp, ph, shm);
#ifdef DUP_S
        if (ph >= 1 && ph < NPHASE - 1) { const int l_ = (ph - 1) / 10, s_ = (ph - 1) % 10;
            if ((l_ & 1) == DUP_PAR || DUP_PAR == 2) {
                if (DUP_S < 10 && s_ == DUP_S) { xcd_barrier(xb); KP kq = kp0; asm volatile("" : "+s"(kq)); run_phase(*(const Params*)kq, (DUP_S == 5 || DUP_S == 9) ? ph + 1000 : ph, shm); }
                if (DUP_S == 30 && s_ == 3) { xcd_barrier(xb); KP kq = kp0; asm volatile("" : "+s"(kq)); run_phase(*(const Params*)kq, ph + 2000, shm); }
                if ((DUP_S == 20 || DUP_S == 21) && s_ == 2) { xcd_barrier(xb); KP kq = kp0; asm volatile("" : "+s"(kq)); run_phase(*(const Params*)kq, ph + (DUP_S == 20 ? 2000 : 3000), shm); }
                if (DUP_S == 23 && s_ == 3) { xcd_barrier(xb); { KP kq = kp0; asm volatile("" : "+s"(kq)); run_phase(*(const Params*)kq, ph - 1, shm); } xcd_barrier(xb); { KP kq = kp0; asm volatile("" : "+s"(kq)); run_phase(*(const Params*)kq, ph, shm); } }
            } }
#endif
        if (ph + 1 < hi) { if (ph == 0) grid.sync(); else xcd_barrier(xb); }
    }
}

#ifndef MK_ONE_LAUNCH
#define MK_ONE_LAUNCH 1
#endif

extern "C" void kernel_launch(void* const* d_in, const int* in_sizes, int n_in, void* d_out, int out_size, void* d_ws, size_t ws_size, hipStream_t stream) {
    static int grid = 0;
    if (grid == 0) {
        if (n_in != N_IN || ws_size < WS_NEED) { fprintf(stderr, "kernel_launch: unexpected n_in %d or ws_size %zu (need %zu)\n", n_in, ws_size, (size_t)WS_NEED); grid = -1; return; }
        int dev = 0, cus = 0, per_cu = 0;
        hipGetDevice(&dev); hipDeviceGetAttribute(&cus, hipDeviceAttributeMultiprocessorCount, dev);
        if (hipFuncSetAttribute((const void*)mk_fwd, hipFuncAttributeMaxDynamicSharedMemorySize, LDS_BYTES) != hipSuccess) { fprintf(stderr, "kernel_launch: hipFuncSetAttribute failed\n"); grid = -1; return; }
        if (hipOccupancyMaxActiveBlocksPerMultiprocessor(&per_cu, (const void*)mk_fwd, 512, LDS_BYTES) != hipSuccess || per_cu < 1) { fprintf(stderr, "kernel_launch: occupancy query failed (%d)\n", per_cu); (void)hipGetLastError(); per_cu = 1; }
        grid = cus * 1;
        if (grid <= 0) grid = 256;
    }
    if (grid < 0) return;
    Params p{};
    for (int i = 0; i < N_IN; ++i) p.in[i] = (const float*)d_in[i];
    p.out = (float*)d_out; p.ws = (unsigned char*)d_ws;
#if MK_ONE_LAUNCH
    p.lo = 0; p.hi = NPHASE;
    if (hipMemsetAsync((char*)d_ws + OFF_BAR, 0, XCD_BAR_WORDS * sizeof(unsigned), stream) != hipSuccess) { fprintf(stderr, "kernel_launch: memset of barrier words failed\n"); return; }
    void* args[] = {&p};
    hipError_t e = hipLaunchCooperativeKernel((const void*)mk_fwd, dim3(grid), dim3(512), args, LDS_BYTES, stream);
    if (e != hipSuccess) fprintf(stderr, "cooperative launch failed: %s (grid %d)\n", hipGetErrorString(e), grid);
#else
#ifndef PROBE_NPH
#define PROBE_NPH NPHASE
#endif
    (void)hipMemsetAsync((char*)d_ws + OFF_BAR, 0, XCD_BAR_WORDS * sizeof(unsigned), stream);
    for (int ph = 0; ph < NPHASE; ++ph) { if (ph >= PROBE_NPH && ph != NPHASE - 1) continue; p.lo = ph; p.hi = ph + 1; hipLaunchKernelGGL(mk_fwd, dim3(grid), dim3(512), LDS_BYTES, stream, p); }
#endif
}
```
